# Optimizing an MI355X kernel written in HIP

```python
import math
import jax, jax.numpy as jnp
from jax import lax
import numpy as np

D_MODEL = 1024
BATCH = 16
SEQ = 4096
DEPTH = 2
DEC_BATCH = 8
DEC_SEQ = 64
PAST_LEN = 4096

CHUNK = 64
Q_BLOCK = 128
A_HEADS = 6
A_QK = 32
A_V = 2 * A_QK
B_GROUPS = 4
B_CH = 64
POOL_WINDOWS = (2, 4, 8, 16)
POOL_HIST = max(POOL_WINDOWS) - 1
C_HEADS = 6
C_NOPE = 64
C_ROPE = 32
C_V = 64
C_Q_RANK = 256
C_KV_RANK = 128
ROPE_BASE = 10000.0
REL_BUCKETS = 32
REL_MAX_DIST = 128
FFN_DIM = 2816
CONV_W = 3
EPS = 1e-6

A_WIDTH = A_HEADS * A_V
B_WIDTH = B_GROUPS * B_CH
C_WIDTH = C_HEADS * C_V
MIX_WIDTH = A_WIDTH + B_WIDTH + C_WIDTH
OFF_AQ = 0
OFF_AK = OFF_AQ + A_HEADS * 2 * A_QK
OFF_AV = OFF_AK + A_HEADS * 2 * A_QK
OFF_B = OFF_AV + A_WIDTH
OFF_CQ = OFF_B + B_WIDTH
OFF_CKV = OFF_CQ + C_Q_RANK
OFF_CKR = OFF_CKV + C_KV_RANK
IN_COLS = OFF_CKR + C_ROPE

kernel_name = "hybrid_streaming_encoder_step"


def rmsnorm(x, g):
    xf = x.astype(jnp.float32)
    y = xf * lax.rsqrt(jnp.mean(xf * xf, axis=-1, keepdims=True) + EPS)
    return (y * g.astype(jnp.float32)).astype(x.dtype)


def apply_rope(x, pos):
    half = C_ROPE // 2
    inv = 1.0 / (ROPE_BASE ** (jnp.arange(half, dtype=jnp.float32) / half))
    ang = pos.astype(jnp.float32)[:, None] * inv[None, :]
    cos, sin = jnp.cos(ang), jnp.sin(ang)
    if x.ndim == 4:
        cos, sin = cos[:, None], sin[:, None]
    xf = x.astype(jnp.float32)
    x1, x2 = xf[..., :half], xf[..., half:]
    return jnp.concatenate([x1 * cos - x2 * sin, x2 * cos + x1 * sin], axis=-1).astype(x.dtype)


def t5_bucket(rel):
    half = REL_BUCKETS // 2
    exact = half // 2
    ret = jnp.where(rel > 0, half, 0)
    n = jnp.abs(rel)
    nf = jnp.maximum(n, 1).astype(jnp.float32)
    large = exact + (jnp.log(nf / exact) / math.log(REL_MAX_DIST / exact) * (half - exact)).astype(jnp.int32)
    large = jnp.minimum(large, half - 1)
    return ret + jnp.where(n < exact, n, large)


def chunk_mask(q_pos, k_pos):
    return (k_pos[None, :] // CHUNK) <= (q_pos[:, None] // CHUNK)


def map_query_blocks(fn, q, q_pos):
    b, t = q.shape[0], q.shape[1]
    if t <= Q_BLOCK or t % Q_BLOCK:
        return fn(q, q_pos)
    nb = t // Q_BLOCK
    qb = q.reshape(b, nb, Q_BLOCK, *q.shape[2:]).swapaxes(0, 1)
    pb = q_pos.reshape(nb, Q_BLOCK)
    out = lax.map(lambda a: fn(a[0], a[1]), (qb, pb))
    out = out.swapaxes(0, 1)
    return out.reshape(b, t, *out.shape[3:])


def diff_attention(q_in, k_in, v_in, past_k, past_v, q_pos, rel_bias, lq1, lk1, lq2, lk2, subln_g, layer_idx):
    b, t, _ = q_in.shape
    q = q_in.reshape(b, t, A_HEADS, 2 * A_QK)
    k = k_in.reshape(b, t, A_HEADS, 2 * A_QK)
    v = v_in.reshape(b, t, A_HEADS, A_V)
    k_all = k if past_k is None else jnp.concatenate([past_k, k], axis=1)
    v_all = v if past_v is None else jnp.concatenate([past_v, v], axis=1)
    k_pos = jnp.arange(k_all.shape[1], dtype=jnp.int32)
    lam_init = 0.8 - 0.6 * math.exp(-0.3 * layer_idx)
    f32 = jnp.float32
    lam = (jnp.exp(jnp.sum(lq1.astype(f32) * lk1.astype(f32)))
           - jnp.exp(jnp.sum(lq2.astype(f32) * lk2.astype(f32))) + lam_init)
    k1 = k_all[..., :A_QK].astype(f32)
    k2 = k_all[..., A_QK:].astype(f32)
    vf = v_all.astype(f32)
    scale = A_QK ** -0.5

    def block(qb, qpb):
        qf = qb.astype(f32)
        bias = rel_bias.astype(f32)[t5_bucket(k_pos[None, :] - qpb[:, None])]
        bias = bias.transpose(2, 0, 1)[None]
        mask = chunk_mask(qpb, k_pos)[None, None]
        s1 = jnp.einsum('bqhd,bkhd->bhqk', qf[..., :A_QK], k1) * scale + bias
        s2 = jnp.einsum('bqhd,bkhd->bhqk', qf[..., A_QK:], k2) * scale + bias
        p = (jax.nn.softmax(jnp.where(mask, s1, -jnp.inf), axis=-1)
             - lam * jax.nn.softmax(jnp.where(mask, s2, -jnp.inf), axis=-1))
        return jnp.einsum('bhqk,bkhd->bqhd', p, vf)

    o = map_query_blocks(block, q, q_pos)
    o = rmsnorm(o, subln_g) * (1.0 - lam_init)
    return o.reshape(b, t, A_WIDTH).astype(v_in.dtype), k, v


def multiscale_pool(u, hist, q_pos, pool_w, pool_scale):
    b, t, _ = u.shape
    if hist is None:
        hist = jnp.zeros((b, POOL_HIST, B_WIDTH), u.dtype)
    ext = jnp.concatenate([hist, u], axis=1)
    cs = jnp.concatenate([jnp.zeros((b, 1, B_WIDTH), jnp.float32),
                          jnp.cumsum(ext.astype(jnp.float32), axis=1)], axis=1)
    uf = u.astype(jnp.float32)
    outs = []
    for g, w in enumerate(POOL_WINDOWS):
        sl = slice(g * B_CH, (g + 1) * B_CH)
        tot = cs[:, POOL_HIST + 1:POOL_HIST + 1 + t, sl] - cs[:, POOL_HIST + 1 - w:POOL_HIST + 1 - w + t, sl]
        cnt = jnp.minimum(q_pos + 1, w).astype(jnp.float32)[None, :, None]
        outs.append(tot / cnt - uf[..., sl])
    m = jnp.stack(outs, axis=2)
    y = jnp.einsum('btgc,gcd->btgd', m, pool_w.astype(jnp.float32)).reshape(b, t, B_WIDTH)
    y = y * pool_scale.astype(jnp.float32)
    return y.astype(u.dtype), ext[:, -POOL_HIST:]


def latent_attention(cq_in, ckv_in, kr_in, past_lat, past_kr, q_pos, q_norm_g, w_q_up, kv_norm_g, w_kv_up):
    b, t, _ = cq_in.shape
    f32 = jnp.float32
    q = (rmsnorm(cq_in, q_norm_g) @ w_q_up).reshape(b, t, C_HEADS, C_NOPE + C_ROPE)
    q = jnp.concatenate([q[..., :C_NOPE], apply_rope(q[..., C_NOPE:], q_pos)], axis=-1)
    lat = rmsnorm(ckv_in, kv_norm_g)
    kr = apply_rope(kr_in, q_pos)
    lat_all = lat if past_lat is None else jnp.concatenate([past_lat, lat], axis=1)
    kr_all = kr if past_kr is None else jnp.concatenate([past_kr, kr], axis=1)
    tk = lat_all.shape[1]
    kv = (lat_all @ w_kv_up).reshape(b, tk, C_HEADS, C_NOPE + C_V)
    k_nope = kv[..., :C_NOPE].astype(f32)
    vf = kv[..., C_NOPE:].astype(f32)
    krf = kr_all.astype(f32)
    k_pos = jnp.arange(tk, dtype=jnp.int32)
    scale = (C_NOPE + C_ROPE) ** -0.5

    def block(qb, qpb):
        qf = qb.astype(f32)
        s = (jnp.einsum('bqhd,bkhd->bhqk', qf[..., :C_NOPE], k_nope)
             + jnp.einsum('bqhd,bkd->bhqk', qf[..., C_NOPE:], krf)) * scale
        mask = chunk_mask(qpb, k_pos)[None, None]
        p = jax.nn.softmax(jnp.where(mask, s, -jnp.inf), axis=-1)
        return jnp.einsum('bhqk,bkhd->bqhd', p, vf)

    o = map_query_blocks(block, q, q_pos)
    return o.reshape(b, t, C_WIDTH).astype(cq_in.dtype), lat, kr


def conv_ffn(h, hist, w_up, conv_w, conv_b, w_down):
    b, t, _ = h.shape
    up = h @ w_up
    g, val = up[..., :FFN_DIM], up[..., FFN_DIM:]
    if hist is None:
        hist = jnp.zeros((b, CONV_W - 1, FFN_DIM), g.dtype)
    ext = jnp.concatenate([hist, g], axis=1)
    gc = sum(conv_w[j] * ext[:, j:j + t] for j in range(CONV_W)) + conv_b
    out = (jax.nn.silu(gc) * val) @ w_down
    return out, ext[:, -(CONV_W - 1):]


def setup_inputs(seed: int = 0) -> dict:
    key = jax.random.key(seed)
    ks = iter(jax.random.split(key, 40))
    D = D_MODEL

    def nrm(shape, s=1.0):
        return jax.random.normal(next(ks), shape, jnp.float32) * s

    def gain(shape):
        return 1.0 + nrm(shape, 0.02)

    return {
        "x_prompt": nrm((BATCH, SEQ, D)),
        "x_sample": nrm((DEC_BATCH, DEC_SEQ, D)),
        "c_prompt": nrm((BATCH, D)),
        "c_sample": nrm((DEC_BATCH, D)),
        "cache_a_k": nrm((DEPTH, DEC_BATCH, PAST_LEN, A_HEADS, 2 * A_QK)),
        "cache_a_v": nrm((DEPTH, DEC_BATCH, PAST_LEN, A_HEADS, A_V)),
        "cache_c_latent": nrm((DEPTH, DEC_BATCH, PAST_LEN, C_KV_RANK)),
        "cache_c_krope": nrm((DEPTH, DEC_BATCH, PAST_LEN, C_ROPE)),
        "state_b_pool": nrm((DEPTH, DEC_BATCH, POOL_HIST, B_WIDTH)),
        "state_ffn_conv": nrm((DEPTH, DEC_BATCH, CONV_W - 1, FFN_DIM)),
        "w_ada": nrm((DEPTH, D, 6 * D), D ** -0.5),
        "b_ada": nrm((DEPTH, 6 * D), 0.02),
        "g_mix": gain((DEPTH, D)),
        "w_in": nrm((DEPTH, D, IN_COLS), D ** -0.5),
        "lam_q1": nrm((DEPTH, A_QK), 0.1),
        "lam_k1": nrm((DEPTH, A_QK), 0.1),
        "lam_q2": nrm((DEPTH, A_QK), 0.1),
        "lam_k2": nrm((DEPTH, A_QK), 0.1),
        "a_subln_g": gain((DEPTH, A_V)),
        "rel_bias": nrm((REL_BUCKETS, A_HEADS), 0.5),
        "pool_w": nrm((DEPTH, B_GROUPS, B_CH, B_CH), B_CH ** -0.5),
        "pool_scale": gain((DEPTH, B_WIDTH)),
        "c_q_norm_g": gain((DEPTH, C_Q_RANK)),
        "w_q_up": nrm((DEPTH, C_Q_RANK, C_HEADS * (C_NOPE + C_ROPE)), C_Q_RANK ** -0.5),
        "c_kv_norm_g": gain((DEPTH, C_KV_RANK)),
        "w_kv_up": nrm((DEPTH, C_KV_RANK, C_HEADS * (C_NOPE + C_V)), C_KV_RANK ** -0.5),
        "w_out": nrm((DEPTH, MIX_WIDTH, D), MIX_WIDTH ** -0.5),
        "g_ffn": gain((DEPTH, D)),
        "w_up": nrm((DEPTH, D, 2 * FFN_DIM), D ** -0.5),
        "conv_w": nrm((DEPTH, CONV_W, FFN_DIM), CONV_W ** -0.5),
        "conv_b": nrm((DEPTH, FFN_DIM), 0.01),
        "w_down": nrm((DEPTH, FFN_DIM, D), FFN_DIM ** -0.5),
        "g_final": gain((D,)),
    }


def reference(x_prompt, x_sample, c_prompt, c_sample, cache_a_k, cache_a_v, cache_c_latent, cache_c_krope,
              state_b_pool, state_ffn_conv, w_ada, b_ada, g_mix, w_in, lam_q1, lam_k1, lam_q2, lam_k2,
              a_subln_g, rel_bias, pool_w, pool_scale, c_q_norm_g, w_q_up, c_kv_norm_g, w_kv_up, w_out,
              g_ffn, w_up, conv_w, conv_b, w_down, g_final):

    def run_layer(l, x, c, q_pos, past):
        pa_k, pa_v, p_lat, p_kr, p_pool, p_conv = past
        mod = jax.nn.silu(c) @ w_ada[l] + b_ada[l]
        sh1, sc1, gt1, sh2, sc2, gt2 = jnp.split(mod[:, None, :], 6, axis=-1)
        h = rmsnorm(x, g_mix[l]) * (1 + sc1) + sh1
        u = h @ w_in[l]
        a_out, a_k, a_v = diff_attention(
            u[..., OFF_AQ:OFF_AK], u[..., OFF_AK:OFF_AV], u[..., OFF_AV:OFF_B], pa_k, pa_v, q_pos,
            rel_bias, lam_q1[l], lam_k1[l], lam_q2[l], lam_k2[l], a_subln_g[l], l)
        b_out, b_hist = multiscale_pool(u[..., OFF_B:OFF_CQ], p_pool, q_pos, pool_w[l], pool_scale[l])
        c_out, c_lat, c_kr = latent_attention(
            u[..., OFF_CQ:OFF_CKV], u[..., OFF_CKV:OFF_CKR], u[..., OFF_CKR:IN_COLS], p_lat, p_kr, q_pos,
            c_q_norm_g[l], w_q_up[l], c_kv_norm_g[l], w_kv_up[l])
        mix = jnp.concatenate([a_out, b_out, c_out], axis=-1) @ w_out[l]
        x = x + gt1 * mix
        h = rmsnorm(x, g_ffn[l]) * (1 + sc2) + sh2
        f, conv_hist = conv_ffn(h, p_conv, w_up[l], conv_w[l], conv_b[l], w_down[l])
        x = x + gt2 * f
        return x, (a_k, a_v, c_lat, c_kr, b_hist, conv_hist)

    pos_p = jnp.arange(x_prompt.shape[1], dtype=jnp.int32)
    pos_s = cache_a_k.shape[2] + jnp.arange(x_sample.shape[1], dtype=jnp.int32)
    hp, hs = x_prompt, x_sample
    new_p, new_s = [], []
    for l in range(DEPTH):
        hp, st_p = run_layer(l, hp, c_prompt, pos_p, (None, None, None, None, None, None))
        new_p.append(st_p)
        hs, st_s = run_layer(l, hs, c_sample, pos_s,
                             (cache_a_k[l], cache_a_v[l], cache_c_latent[l], cache_c_krope[l],
                              state_b_pool[l], state_ffn_conv[l]))
        new_s.append(st_s)
    y_prompt = rmsnorm(hp, g_final)
    y_sample = rmsnorm(hs, g_final)
    a_k_p, a_v_p, lat_p, kr_p, pool_p, conv_p = [jnp.stack(z, axis=0) for z in zip(*new_p)]
    a_k_s, a_v_s, lat_s, kr_s, pool_s, conv_s = [jnp.stack(z, axis=0) for z in zip(*new_s)]
    return (y_prompt, y_sample, a_k_p, a_v_p, lat_p, kr_p, pool_p, conv_p,
            a_k_s, a_v_s, lat_s, kr_s, pool_s, conv_s)
```

```cpp
#include <hip/hip_runtime.h>
#include <hip/hip_cooperative_groups.h>
#include <cstdio>
#include <cstdint>
#include <cmath>
namespace cg = cooperative_groups;

#ifndef PG8_ALIGN_EPI
#define PG8_ALIGN_EPI 1
#endif
#ifndef N_LAUNCH_MODE
#define N_LAUNCH_MODE 1
#endif

#define LAS __attribute__((address_space(3)))
typedef unsigned short bf16_t;
typedef short bf16x8 __attribute__((ext_vector_type(8)));
typedef short s16x4 __attribute__((ext_vector_type(4)));
typedef float f32x4 __attribute__((ext_vector_type(4)));
typedef float f32x16 __attribute__((ext_vector_type(16)));
typedef unsigned u32x4 __attribute__((ext_vector_type(4)));
typedef unsigned u32x2 __attribute__((ext_vector_type(2)));
typedef float f32x2_t __attribute__((ext_vector_type(2)));
typedef __bf16 bf16x2_t __attribute__((ext_vector_type(2)));
typedef short v4i16_t __attribute__((ext_vector_type(4)));

constexpr int DM = 1024, NBP = 16, TP = 4096, NBS = 8, TS = 64, PAST = 4096;
constexpr int MP = NBP * TP, MS = NBS * TS, MT = MP + MS;
constexpr int TKS = PAST + TS;
constexpr int MKV = MP + NBS * TKS;
constexpr int INC = 1824, INPAD = 2048, FFN = 2816;
constexpr int NGRP = MT / 64;
constexpr float EPS = 1e-6f;
constexpr float LOG2E = 1.4426950408889634f;

constexpr size_t O_YP = 0;
constexpr size_t O_YS = O_YP + (size_t)MP * DM;
constexpr size_t O_AKP = O_YS + (size_t)MS * DM;
constexpr size_t O_AVP = O_AKP + (size_t)2 * MP * 384;
constexpr size_t O_LATP = O_AVP + (size_t)2 * MP * 384;
constexpr size_t O_KRP = O_LATP + (size_t)2 * MP * 128;
constexpr size_t O_POOLP = O_KRP + (size_t)2 * MP * 32;
constexpr size_t O_CONVP = O_POOLP + (size_t)2 * NBP * 15 * 256;
constexpr size_t O_AKS = O_CONVP + (size_t)2 * NBP * 2 * FFN;
constexpr size_t O_AVS = O_AKS + (size_t)2 * MS * 384;
constexpr size_t O_LATS = O_AVS + (size_t)2 * MS * 384;
constexpr size_t O_KRS = O_LATS + (size_t)2 * MS * 128;
constexpr size_t O_POOLS = O_KRS + (size_t)2 * MS * 32;
constexpr size_t O_CONVS = O_POOLS + (size_t)2 * NBS * 15 * 256;
constexpr size_t O_END = O_CONVS + (size_t)2 * NBS * 2 * FFN;

constexpr size_t al256(size_t x) { return (x + 255) & ~(size_t)255; }
constexpr size_t WS_CTL = 0;
constexpr size_t WS_BAR = 4096;
constexpr size_t WS_WIN = 32768;
constexpr size_t WS_WQUP = WS_WIN + (size_t)2 * INPAD * 1024 * 2;
constexpr size_t WS_WKV = WS_WQUP + (size_t)2 * 768 * 256 * 2;
constexpr size_t WS_WOUT = WS_WKV + (size_t)2 * 768 * 128 * 2;
constexpr size_t WS_WUP = WS_WOUT + (size_t)2 * 1024 * 1024 * 2;
constexpr size_t WS_WDN = WS_WUP + (size_t)2 * 5632 * 1024 * 2;
constexpr size_t WS_MOD = WS_WDN + (size_t)2 * 1024 * FFN * 2;
constexpr size_t WS_ROPE = WS_MOD + (size_t)2 * 24 * 6144 * 4;
constexpr size_t WS_RS = al256(WS_ROPE + (size_t)TKS * 16 * 2 * 4);
constexpr size_t WS_SHW1 = WS_RS + (size_t)4 * MT * 4;
constexpr size_t WS_SHW2 = WS_SHW1 + (size_t)2 * 24 * INPAD * 4;
constexpr size_t WS_H = al256(WS_SHW2 + (size_t)2 * 24 * 5632 * 4);
constexpr size_t WS_LAT = WS_H + (size_t)MT * 1024 * 2;
constexpr size_t WS_KR = WS_LAT + (size_t)MKV * 128 * 2;
constexpr size_t WS_KS = WS_KR + (size_t)MKV * 32 * 2;
constexpr size_t WS_VS = WS_KS + (size_t)NBS * TKS * 384 * 2;
constexpr size_t WS_MIX = WS_VS + (size_t)NBS * TKS * 384 * 2;
constexpr size_t WS_FIX = WS_MIX + (size_t)MT * 1024 * 2;
constexpr size_t WS_U = WS_FIX + (size_t)NGRP * 6 * FFN * 4;
constexpr size_t WS_CQN = WS_U + (size_t)MT * INC * 2;
constexpr size_t WS_QC = WS_CQN + (size_t)MT * 256 * 2;
constexpr size_t WS_KVX = WS_QC + (size_t)MT * 576 * 2;
constexpr size_t WS_END = WS_KVX + (size_t)MKV * 768 * 2;
constexpr size_t WS_ACT = WS_U;
static_assert(WS_ACT + (size_t)MT * FFN * 2 <= WS_END, "act overlay");
static_assert(WS_END <= (size_t)1073741824, "workspace");

constexpr int LDS_BYTES = 147456 + 64;
constexpr int LDS_BARST = 147456;
constexpr int NTHREADS = 512;

struct Args {
    const float* in[33];
    float* out; unsigned char* ws;
    float inv_freq[16];
    int ph_lo, ph_hi;
};

__device__ __forceinline__ int otid(int wv) { (void)wv; int t = threadIdx.x; asm volatile("" : "+v"(t)); return t; }
__device__ __forceinline__ unsigned cvtpk(float lo, float hi) { f32x2_t v = {lo, hi}; bf16x2_t b = __builtin_convertvector(v, bf16x2_t); return __builtin_bit_cast(unsigned, b); }
__device__ __forceinline__ float bf2f(unsigned short x) { return __uint_as_float((unsigned)x << 16); }
__device__ __forceinline__ float wave_sum(float v) {
#pragma unroll
    for (int o = 32; o >= 1; o >>= 1) v += __shfl_xor(v, o);
    return v;
}
__device__ __forceinline__ int batch_of(int row) { return row < MP ? (row >> 12) : 16 + ((row - MP) >> 6); }
__device__ __forceinline__ int pos_of(int row) { return row < MP ? (row & 4095) : PAST + ((row - MP) & 63); }
__device__ __forceinline__ size_t kvrow_of(int row) { return row < MP ? (size_t)row : (size_t)MP + (size_t)((row - MP) >> 6) * TKS + PAST + ((row - MP) & 63); }

#define XB_TMO      128
#define XB_XCNT(j)  (256  + 64 * (j))
#define XB_XSUB(j)  (1280 + 64 * (j))
#define XB_XGEN(j)  (2304 + 64 * (j))
#define XB_TOP      3328
#define XB_TOPGEN   3392
#define XCD_BAR_WORDS 3456
#define XB_SPIN_CAP (1u << 18)
__device__ __forceinline__ unsigned xb_ld(unsigned* p)              { return __hip_atomic_load(p, __ATOMIC_RELAXED, __HIP_MEMORY_SCOPE_AGENT); }
__device__ __forceinline__ unsigned xb_add(unsigned* p, unsigned v) { return __hip_atomic_fetch_add(p, v, __ATOMIC_RELAXED, __HIP_MEMORY_SCOPE_AGENT); }
__device__ __forceinline__ unsigned xb_xcc_id() { return (unsigned)__builtin_amdgcn_s_getreg((3 << 11) | 20) & 0xFu; }
#define XB_SPIN(cond, bar) do { unsigned _sp = 0; while (cond) { __builtin_amdgcn_s_sleep(1); \
    if ((++_sp & 255u) == 0u) { if (xb_ld(&(bar)[XB_TMO])) break; if (_sp > XB_SPIN_CAP) { atomicAdd(&(bar)[XB_TMO], 1u); break; } } } } while (0)
struct XcdBarrier { unsigned* bar; unsigned x; volatile LAS unsigned* st; int wv; };
__device__ __forceinline__ XcdBarrier xcd_barrier_post(unsigned* bar, volatile LAS unsigned* st, int wv) {
    XcdBarrier b; b.bar = bar; b.x = xb_xcc_id(); b.st = st; b.wv = wv;
    if (otid(wv) == 0) (void)xb_add(&bar[XB_XCNT(b.x)], 1u);
    return b;
}
__device__ __forceinline__ void xcd_barrier_complete(unsigned* bar, unsigned x, unsigned& nloc, unsigned& nx) {
    const unsigned G = gridDim.x * gridDim.y * gridDim.z;
    unsigned sum, cnt, mine, sp = 0u;
    for (;;) {
        sum = 0u; cnt = 0u; mine = 0u;
#pragma unroll
        for (unsigned j = 0; j < 16; ++j) { const unsigned c = xb_ld(&bar[XB_XCNT(j)]); sum += c; cnt += (c > 0u) ? 1u : 0u; mine = (j == x) ? c : mine; }
        if (sum == G) break;
        __builtin_amdgcn_s_sleep(1);
        if ((++sp & 255u) == 0u) { if (xb_ld(&bar[XB_TMO])) break; if (sp > XB_SPIN_CAP) { atomicAdd(&bar[XB_TMO], 1u); break; } }
    }
    nloc = mine > 0u ? mine : 1u; nx = cnt > 0u ? cnt : 1u;
}
__device__ __forceinline__ void xcd_barrier(const XcdBarrier& b) {
    asm volatile("s_waitcnt vmcnt(0)" ::: "memory");
    __syncthreads();
    if (otid(b.wv) == 0) {
        unsigned* bar = b.bar;
        __builtin_amdgcn_s_waitcnt(0);
        unsigned nloc = b.st[0], nx = b.st[1];
        if (nloc == 0u) { xcd_barrier_complete(bar, b.x, nloc, nx); b.st[0] = nloc; b.st[1] = nx; }
        const unsigned old = xb_add(&bar[XB_XSUB(b.x)], 1u);
        const unsigned gen = old / nloc;
        if (old + 1u == (gen + 1u) * nloc) {
            __builtin_amdgcn_fence(__ATOMIC_RELEASE, "agent");
            asm volatile("s_waitcnt vmcnt(0)" ::: "memory");
            const unsigned og = xb_add(&bar[XB_TOP], 1u);
            const unsigned tg = og / nx;
            if (og + 1u == (tg + 1u) * nx) xb_add(&bar[XB_TOPGEN], 1u);
            else XB_SPIN(xb_ld(&bar[XB_TOPGEN]) == tg, bar);
            __builtin_amdgcn_fence(__ATOMIC_ACQUIRE, "agent");
            xb_add(&bar[XB_XGEN(b.x)], 1u);
            asm volatile("s_waitcnt vmcnt(0)" ::: "memory");
        } else {
            XB_SPIN(xb_ld(&bar[XB_XGEN(b.x)]) == gen, bar);
            __builtin_amdgcn_fence(__ATOMIC_ACQUIRE, "agent");
            asm volatile("s_waitcnt vmcnt(0)" ::: "memory");
        }
    }
    __syncthreads();
}

__device__ __forceinline__ void publish_count(unsigned* cnt, int tid) {
    asm volatile("s_waitcnt vmcnt(0)" ::: "memory");
    __syncthreads();
    if (tid == 0) {
        __builtin_amdgcn_fence(__ATOMIC_RELEASE, "agent");
        asm volatile("s_waitcnt vmcnt(0)" ::: "memory");
        __hip_atomic_fetch_add(cnt, 1u, __ATOMIC_RELAXED, __HIP_MEMORY_SCOPE_AGENT);
    }
}
__device__ __forceinline__ void wait_count(unsigned* cnt, unsigned need) {
    unsigned sp = 0;
    while (__hip_atomic_load(cnt, __ATOMIC_RELAXED, __HIP_MEMORY_SCOPE_AGENT) < need) { __builtin_amdgcn_s_sleep(2); if (++sp > (1u << 22)) break; }
    __builtin_amdgcn_fence(__ATOMIC_ACQUIRE, "agent");
    asm volatile("s_waitcnt vmcnt(0)" ::: "memory");
}

namespace pg8 {
constexpr int BM = 256, BK = 64, HALF = 128, HTB = HALF * BK * 2, NXCD = 8, WGM = 8;
__host__ __device__ __forceinline__ int lds_byte(int r, int c) { const int st = (r >> 4) * 2 + (c >> 5), rr = r & 15, cc = c & 31, ob = rr * 64 + cc * 2; return st * 1024 + (ob ^ (((ob >> 9) & 1) << 5)); }
__host__ __device__ __forceinline__ void stage_rc(int b, int& R, int& C) { const int st = b / 1024, sb = b % 1024, swz = sb ^ (((sb >> 9) & 1) << 5); R = (st >> 1) * 16 + swz / 64; C = (st & 1) * 32 + (swz % 64) / 2; }
__host__ __device__ __forceinline__ int perm32(int rho) { const int n = rho >> 4, i = rho & 15; return 8 * (i >> 2) + 4 * n + (i & 3); }
struct Unit { int pm, pn; };
struct Gemm { const bf16_t* A; const bf16_t* Bt; int M, N, K; };
struct StaticOrder {
    int nM, nN, nwg, G, c;
    __device__ void init(int M, int N, int G_, int c_) { nM = M / BM; nN = N / BM; nwg = nM * nN; G = G_; c = c_; }
    __device__ bool next(int i, Unit& u) const {
        const long L = (long)i * G + c; if (L >= nwg) return false;
        int wgid = (int)L; { const int q = nwg / NXCD, r = nwg % NXCD, xcd = wgid % NXCD, off = wgid / NXCD; wgid = (xcd < r ? xcd * (q + 1) : r * (q + 1) + (xcd - r) * q) + off; }
        const int nig = WGM * nN, gid = wgid / nig, fm = gid * WGM, gsz = (nM - fm) < WGM ? (nM - fm) : WGM;
        u.pm = fm + ((wgid % nig) % gsz); u.pn = (wgid % nig) / gsz; return true;
    }
    __device__ __forceinline__ void a_ready(const Unit&) const {}
};
struct OneUnit {
    int pm, pn;
    __device__ bool next(int i, Unit& u) const { if (i != 0) return false; u.pm = pm; u.pn = pn; return true; }
    __device__ __forceinline__ void a_ready(const Unit&) const {}
};
struct GatedOrder {
    StaticOrder so; unsigned* cnt; unsigned need; int gate_pm;
    __device__ bool next(int i, Unit& u) const { return so.next(i, u); }
    __device__ __forceinline__ void a_ready(const Unit& u) const {
        if (u.pm >= gate_pm) {
            unsigned sp = 0;
            while (__hip_atomic_load(cnt, __ATOMIC_RELAXED, __HIP_MEMORY_SCOPE_AGENT) < need) { __builtin_amdgcn_s_sleep(2); if (++sp > (1u << 22)) break; }
            __builtin_amdgcn_fence(__ATOMIC_ACQUIRE, "agent");
            asm volatile("s_waitcnt vmcnt(0)" ::: "memory");
        }
    }
};
template <class Epi, class Sched>
__device__ __forceinline__ void gemm_phase(LAS unsigned char* lds, const Gemm g, const Sched& S, const Epi& E, int wv) {
    const int tid = otid(wv);
    const int wid = __builtin_amdgcn_readfirstlane(tid >> 6), lane = tid & 63, wr = wid >> 2, wc = wid & 3, fr = lane & 15, fq = lane >> 4;
    int K = g.K; asm volatile("" : "+s"(K));
    const int nt = K / BK;
    unsigned voffA[2], voffB[2];
#pragma unroll
    for (int i = 0; i < 2; ++i) { int R, C; stage_rc(tid * 16 + i * 8192, R, C); const int Rb = (R & ~31) + perm32(R & 31);
        voffA[i] = (unsigned)(R * K + C) * 2u; voffB[i] = (unsigned)(Rb * K + C) * 2u; }
    const size_t kstep = (size_t)(BK * 2);
    const size_t hstep = (size_t)HALF * K * 2;
    const size_t tstep = 2 * hstep;
    const unsigned ldsw = (unsigned)wid * 1024u;
    const int aoff = lds_byte(wr * 64 + fr, fq * 8), boff = lds_byte(wc * 32 + fr, fq * 8);
#define PG8_SA(b, h) (((b) * 2 + (h)) * HTB)
#define PG8_SB(b, h) ((4 + (b) * 2 + (h)) * HTB)
#define PG8_STAGE(bufoff, gbase, voff) do { _Pragma("unroll") for (int _i = 0; _i < 2; ++_i) \
        __builtin_amdgcn_global_load_lds((const unsigned*)((const char*)(gbase) + (voff)[_i]), (LAS unsigned*)(lds + (bufoff) + ldsw + _i * 8192), 16, 0, 0); } while (0)
#define PG8_LDA(dst, b, h) do { _Pragma("unroll") for (int m = 0; m < 4; ++m) _Pragma("unroll") for (int k = 0; k < 2; ++k) dst[m][k] = *(const LAS bf16x8*)(lds + PG8_SA(b, h) + aoff + m * 2048 + k * 1024); } while (0)
#define PG8_LDB(dst, b, h) do { _Pragma("unroll") for (int n = 0; n < 2; ++n) _Pragma("unroll") for (int k = 0; k < 2; ++k) dst[n][k] = *(const LAS bf16x8*)(lds + PG8_SB(b, h) + boff + n * 2048 + k * 1024); } while (0)
#define PG8_MMA(ai, bj, At, Bt) do { __builtin_amdgcn_s_setprio(1); _Pragma("unroll") for (int m = 0; m < 4; ++m) _Pragma("unroll") for (int n = 0; n < 2; ++n) _Pragma("unroll") for (int k = 0; k < 2; ++k) \
        acc[ai][bj][m][n] = __builtin_amdgcn_mfma_f32_16x16x32_bf16(Bt[n][k], At[m][k], acc[ai][bj][m][n], 0, 0, 0); __builtin_amdgcn_s_setprio(0); } while (0)
#define PG8_WAIT_V(n) asm volatile("s_waitcnt vmcnt(" #n ")" ::: "memory")
#define PG8_WAIT_L(n) asm volatile("s_waitcnt lgkmcnt(" #n ")" ::: "memory")
#define PG8_BAR __builtin_amdgcn_s_barrier()
#define PG8_SCHED __builtin_amdgcn_sched_barrier(0)
    Unit cur, nxt; int ui = 0;
    if (!S.next(0, cur)) return;
    f32x4 acc[2][2][4][2];
#pragma unroll
    for (int a = 0; a < 2; ++a)
#pragma unroll
        for (int b = 0; b < 2; ++b)
#pragma unroll
            for (int m = 0; m < 4; ++m)
#pragma unroll
                for (int n = 0; n < 2; ++n) acc[a][b][m][n] = (f32x4){0.f, 0.f, 0.f, 0.f};
    bf16x8 At[4][2], B0[2][2], B1[2][2];
    const char* cA = (const char*)g.A + (size_t)cur.pm * tstep; const char* cB = (const char*)g.Bt + (size_t)cur.pn * tstep;
    S.a_ready(cur);
    PG8_STAGE(PG8_SB(0, 0), cB, voffB); PG8_STAGE(PG8_SB(0, 1), cB + hstep, voffB); PG8_STAGE(PG8_SA(0, 0), cA, voffA); PG8_STAGE(PG8_SA(0, 1), cA + hstep, voffA);
    if (wr == 1) PG8_BAR;
    PG8_WAIT_V(2); PG8_BAR;
    PG8_STAGE(PG8_SB(1, 0), cB + kstep, voffB); PG8_STAGE(PG8_SA(1, 0), cA + kstep, voffA); PG8_STAGE(PG8_SB(1, 1), cB + hstep + kstep, voffB);
    PG8_WAIT_V(6); PG8_BAR;
    for (;;) {
        const bool has_next = S.next(ui + 1, nxt);
        const char* nA = has_next ? (const char*)g.A + (size_t)nxt.pm * tstep : cA; const char* nB = has_next ? (const char*)g.Bt + (size_t)nxt.pn * tstep : cB;
        for (int t = 0; t < nt; t += 2) {
            const bool last = (t == nt - 2);
            const char* a1 = cA + (size_t)(t + 1) * kstep;
            const char* a2 = last ? nA : cA + (size_t)(t + 2) * kstep; const char* b2 = last ? nB : cB + (size_t)(t + 2) * kstep;
            const char* a3 = a2 + kstep; const char* b3 = b2 + kstep;
            if (last && has_next) S.a_ready(nxt);
            PG8_LDB(B0, 0, 0); PG8_LDB(B1, 0, 1); PG8_SCHED; PG8_LDA(At, 0, 0); PG8_STAGE(PG8_SA(1, 1), a1 + hstep, voffA);
            PG8_WAIT_V(8); PG8_WAIT_L(0); PG8_BAR; PG8_MMA(0, 0, At, B0); PG8_MMA(0, 1, At, B1); PG8_BAR; PG8_SCHED;
            PG8_LDA(At, 0, 1); PG8_STAGE(PG8_SB(0, 0), b2, voffB); PG8_STAGE(PG8_SB(0, 1), b2 + hstep, voffB); PG8_STAGE(PG8_SA(0, 0), a2, voffA);
            PG8_WAIT_V(8); PG8_WAIT_L(0); PG8_BAR; PG8_MMA(1, 0, At, B0); PG8_MMA(1, 1, At, B1); PG8_BAR; PG8_SCHED;
            PG8_LDB(B0, 1, 0); PG8_LDB(B1, 1, 1); PG8_SCHED; PG8_LDA(At, 1, 0); PG8_STAGE(PG8_SA(0, 1), a2 + hstep, voffA);
            PG8_WAIT_V(8); PG8_WAIT_L(0); PG8_BAR; PG8_MMA(0, 0, At, B0); PG8_MMA(0, 1, At, B1); PG8_BAR; PG8_SCHED;
            PG8_LDA(At, 1, 1); PG8_STAGE(PG8_SB(1, 0), b3, voffB); PG8_STAGE(PG8_SB(1, 1), b3 + hstep, voffB); PG8_STAGE(PG8_SA(1, 0), a3, voffA);
            PG8_WAIT_V(8); PG8_WAIT_L(0); PG8_BAR; PG8_MMA(1, 0, At, B0); PG8_MMA(1, 1, At, B1); PG8_BAR; PG8_SCHED;
        }
#if PG8_ALIGN_EPI
        if (wr == 0) PG8_BAR;
#endif
        E(acc, cur, wr, wc, fr, fq);
        if (!has_next) break;
#pragma unroll
        for (int a = 0; a < 2; ++a)
#pragma unroll
            for (int b = 0; b < 2; ++b)
#pragma unroll
                for (int m = 0; m < 4; ++m)
#pragma unroll
                    for (int n = 0; n < 2; ++n) acc[a][b][m][n] = (f32x4){0.f, 0.f, 0.f, 0.f};
        cur = nxt; cA = nA; cB = nB; ++ui;
#if PG8_ALIGN_EPI
        if (wr == 1) PG8_BAR;
#endif
    }
    PG8_WAIT_V(0);
#if !PG8_ALIGN_EPI
    if (wr == 0) PG8_BAR;
#endif
    PG8_BAR;
#undef PG8_SA
#undef PG8_SB
#undef PG8_STAGE
#undef PG8_LDA
#undef PG8_LDB
#undef PG8_MMA
#undef PG8_WAIT_V
#undef PG8_WAIT_L
#undef PG8_BAR
#undef PG8_SCHED
}

#define EPI_ROW(u, ai, wr, m, fr) ((u).pm * 256 + (ai) * 128 + (wr) * 64 + (m) * 16 + (fr))

struct EpiInProj {
    bf16_t* U; float* akp; float* aks; float* avp; float* avs; float* poolp; float* pools;
    const float* rs; const float* shw;
    __device__ __forceinline__ void operator()(const f32x4 (&acc)[2][2][4][2], const Unit& u, int wr, int wc, int fr, int fq) const {
#pragma unroll
        for (int bj = 0; bj < 2; ++bj) {
            const int c0 = u.pn * 256 + bj * 128 + wc * 32 + 8 * fq;
            if (c0 >= INC) continue;
#pragma unroll
            for (int ai = 0; ai < 2; ++ai)
#pragma unroll
                for (int m = 0; m < 4; ++m) {
                    const int r = EPI_ROW(u, ai, wr, m, fr);
                    f32x4 v0 = acc[ai][bj][m][0], v1 = acc[ai][bj][m][1];
                    if (rs) {
                        const float rstd = rsqrtf(rs[r] * (1.f / 1024.f) + EPS);
                        const float* sp = shw + (size_t)batch_of(r) * INPAD + c0;
                        v0 = v0 * rstd + *(const f32x4*)sp; v1 = v1 * rstd + *(const f32x4*)(sp + 4);
                    }
                    u32x4 w; w.x = cvtpk(v0[0], v0[1]); w.y = cvtpk(v0[2], v0[3]); w.z = cvtpk(v1[0], v1[1]); w.w = cvtpk(v1[2], v1[3]);
                    *(u32x4*)(U + (size_t)r * INC + c0) = w;
                    if (c0 >= 384 && c0 < 768) {
                        float* o = (r < MP) ? akp + (size_t)r * 384 : aks + (size_t)(r - MP) * 384; o += c0 - 384;
                        __builtin_nontemporal_store(v0, (f32x4*)o); __builtin_nontemporal_store(v1, (f32x4*)(o + 4));
                    } else if (c0 >= 768 && c0 < 1152) {
                        float* o = (r < MP) ? avp + (size_t)r * 384 : avs + (size_t)(r - MP) * 384; o += c0 - 768;
                        __builtin_nontemporal_store(v0, (f32x4*)o); __builtin_nontemporal_store(v1, (f32x4*)(o + 4));
                    } else if (c0 >= 1152 && c0 < 1408) {
                        if (r < MP) { const int t = r & 4095; if (t >= TP - 15) { float* o = poolp + ((size_t)(r >> 12) * 15 + (t - (TP - 15))) * 256 + (c0 - 1152); *(f32x4*)o = v0; *(f32x4*)(o + 4) = v1; } }
                        else { const int rs = r - MP, t = rs & 63; if (t >= TS - 15) { float* o = pools + ((size_t)(rs >> 6) * 15 + (t - (TS - 15))) * 256 + (c0 - 1152); *(f32x4*)o = v0; *(f32x4*)(o + 4) = v1; } }
                    }
                }
        }
    }
};

struct EpiQup {
    bf16_t* QC; const float* rope;
    __device__ __forceinline__ void operator()(const f32x4 (&acc)[2][2][4][2], const Unit& u, int wr, int wc, int fr, int fq) const {
#pragma unroll
        for (int bj = 0; bj < 2; ++bj) {
            const int cb = u.pn * 256 + bj * 128 + wc * 32;
            if (cb >= 576) continue;
            const int c0 = cb + 8 * fq;
            const bool isrope = (cb % 96) == 64;
#pragma unroll
            for (int ai = 0; ai < 2; ++ai)
#pragma unroll
                for (int m = 0; m < 4; ++m) {
                    const int r = EPI_ROW(u, ai, wr, m, fr);
                    float v[8];
#pragma unroll
                    for (int e = 0; e < 4; ++e) { v[e] = acc[ai][bj][m][0][e]; v[4 + e] = acc[ai][bj][m][1][e]; }
                    if (isrope) {
                        const int pos = pos_of(r);
                        const int i0 = (8 * fq) & 15;
                        const float* rp = rope + ((size_t)pos * 16 + i0) * 2;
                        const float sg = (fq < 2) ? -1.f : 1.f;
#pragma unroll
                        for (int e2 = 0; e2 < 4; ++e2) {
                            const f32x4 t4 = *(const f32x4*)(rp + 4 * e2);
                            const float pv0 = __shfl_xor(v[2 * e2], 32), pv1 = __shfl_xor(v[2 * e2 + 1], 32);
                            v[2 * e2] = v[2 * e2] * t4[0] + sg * pv0 * t4[1];
                            v[2 * e2 + 1] = v[2 * e2 + 1] * t4[2] + sg * pv1 * t4[3];
                        }
                    }
                    u32x4 w; w.x = cvtpk(v[0], v[1]); w.y = cvtpk(v[2], v[3]); w.z = cvtpk(v[4], v[5]); w.w = cvtpk(v[6], v[7]);
                    *(u32x4*)(QC + (size_t)r * 576 + c0) = w;
                    __builtin_amdgcn_sched_barrier(0);
                }
        }
    }
};

struct EpiBf16 {
    bf16_t* O; int ldc;
    __device__ __forceinline__ void operator()(const f32x4 (&acc)[2][2][4][2], const Unit& u, int wr, int wc, int fr, int fq) const {
#pragma unroll
        for (int bj = 0; bj < 2; ++bj) {
            const int c0 = u.pn * 256 + bj * 128 + wc * 32 + 8 * fq;
#pragma unroll
            for (int ai = 0; ai < 2; ++ai)
#pragma unroll
                for (int m = 0; m < 4; ++m) {
                    const int r = EPI_ROW(u, ai, wr, m, fr);
                    const f32x4 v0 = acc[ai][bj][m][0], v1 = acc[ai][bj][m][1];
                    u32x4 w; w.x = cvtpk(v0[0], v0[1]); w.y = cvtpk(v0[2], v0[3]); w.z = cvtpk(v1[0], v1[1]); w.w = cvtpk(v1[2], v1[3]);
                    *(u32x4*)(O + (size_t)r * ldc + c0) = w;
                }
        }
    }
};

struct EpiRes {
    const float* xp; const float* xs; bool from_input; const float* xbuf; float* xdst; const float* gate;
    bf16_t* Hn; const float* gn; const float* scn; float* rsn;
    __device__ __forceinline__ void operator()(const f32x4 (&acc)[2][2][4][2], const Unit& u, int wr, int wc, int fr, int fq) const {
        const int c00 = u.pn * 256 + wc * 32 + 8 * fq;
#pragma unroll
        for (int ai = 0; ai < 2; ++ai) {
            const int rbase = u.pm * 256 + ai * 128 + wr * 64 + fr;
            const int b = batch_of(rbase);
            f32x4 gt[2][2], gh[2][2];
#pragma unroll
            for (int bj = 0; bj < 2; ++bj) {
                const int c0 = c00 + bj * 128;
                const float* gp = gate + (size_t)b * 6144 + c0;
                gt[bj][0] = *(const f32x4*)gp; gt[bj][1] = *(const f32x4*)(gp + 4);
                if (Hn) {
                    const float* sp = scn + (size_t)b * 6144 + c0;
                    gh[bj][0] = *(const f32x4*)(gn + c0) * (*(const f32x4*)sp + 1.f); gh[bj][1] = *(const f32x4*)(gn + c0 + 4) * (*(const f32x4*)(sp + 4) + 1.f);
                }
            }
#pragma unroll
            for (int mp = 0; mp < 2; ++mp) {
                f32x4 xv[2][2][2];
#pragma unroll
                for (int m2 = 0; m2 < 2; ++m2) {
                    const int r = rbase + 16 * (2 * mp + m2);
                    const float* xo = from_input ? ((r < MP) ? xp + (size_t)r * DM : xs + (size_t)(r - MP) * DM) : xbuf + (size_t)r * DM;
#pragma unroll
                    for (int bj = 0; bj < 2; ++bj) { xv[m2][bj][0] = *(const f32x4*)(xo + c00 + bj * 128); xv[m2][bj][1] = *(const f32x4*)(xo + c00 + bj * 128 + 4); }
                }
#pragma unroll
                for (int m2 = 0; m2 < 2; ++m2) {
                    const int m = 2 * mp + m2;
                    const int r = rbase + 16 * m;
                    float ss = 0.f;
#pragma unroll
                    for (int bj = 0; bj < 2; ++bj) {
                        const int c0 = c00 + bj * 128;
                        float* xn = xdst + (size_t)r * DM + c0;
                        const f32x4 y0 = xv[m2][bj][0] + gt[bj][0] * acc[ai][bj][m][0], y1 = xv[m2][bj][1] + gt[bj][1] * acc[ai][bj][m][1];
                        *(f32x4*)xn = y0; *(f32x4*)(xn + 4) = y1;
                        if (Hn) {
                            ss += y0[0] * y0[0] + y0[1] * y0[1] + y0[2] * y0[2] + y0[3] * y0[3] + y1[0] * y1[0] + y1[1] * y1[1] + y1[2] * y1[2] + y1[3] * y1[3];
                            const f32x4 h0 = y0 * gh[bj][0], h1 = y1 * gh[bj][1];
                            u32x4 w; w.x = cvtpk(h0[0], h0[1]); w.y = cvtpk(h0[2], h0[3]); w.z = cvtpk(h1[0], h1[1]); w.w = cvtpk(h1[2], h1[3]);
                            *(u32x4*)(Hn + (size_t)r * DM + c0) = w;
                        }
                    }
                    if (Hn) {
                        ss += __shfl_xor(ss, 16); ss += __shfl_xor(ss, 32);
                        if (fq == 0) atomicAdd(rsn + r, ss);
                    }
                }
            }
            __builtin_amdgcn_sched_barrier(0);
        }
    }
};

__device__ __forceinline__ float silu_f(float x) { return x * __builtin_amdgcn_rcpf(1.f + __expf(-x)); }
struct EpiUp {
    bf16_t* ACT; float* FIX; const float* cw; const float* cb; float* convp; float* convs;
    const float* rs; const float* shw;
    __device__ __forceinline__ void operator()(const f32x4 (&acc)[2][2][4][2], const Unit& u, int wr, int wc, int fr, int fq) const {
        const int cg0 = u.pn * 128 + wc * 32 + 8 * fq;
        const int cn0 = u.pn * 256 + wc * 32 + 8 * fq;
        float w0[8], w1[8], w2[8], bb[8];
#pragma unroll
        for (int e = 0; e < 8; ++e) { w0[e] = cw[cg0 + e]; w1[e] = cw[FFN + cg0 + e]; w2[e] = cw[2 * FFN + cg0 + e]; bb[e] = cb[cg0 + e]; }
#pragma unroll
        for (int ai = 0; ai < 2; ++ai) {
            const int grp = (u.pm * 256 + ai * 128 + wr * 64) >> 6;
            float sg[8], sv[8];
            {
                const float* sp = shw + (size_t)batch_of(grp * 64) * 5632 + cn0;
#pragma unroll
                for (int e = 0; e < 8; ++e) { sg[e] = sp[e]; sv[e] = sp[128 + e]; }
            }
            float p1[8], p2[8];
#pragma unroll
            for (int e = 0; e < 8; ++e) { p1[e] = 0.f; p2[e] = 0.f; }
#pragma unroll
            for (int m = 0; m < 4; ++m) {
                const int r = EPI_ROW(u, ai, wr, m, fr);
                float g[8], v[8], o[8];
#pragma unroll
                for (int e = 0; e < 4; ++e) { g[e] = acc[ai][0][m][0][e]; g[4 + e] = acc[ai][0][m][1][e]; v[e] = acc[ai][1][m][0][e]; v[4 + e] = acc[ai][1][m][1][e]; }
                {
                    const float rstd = rsqrtf(rs[r] * (1.f / 1024.f) + EPS);
#pragma unroll
                    for (int e = 0; e < 8; ++e) { g[e] = g[e] * rstd + sg[e]; v[e] = v[e] * rstd + sv[e]; }
                }
#pragma unroll
                for (int e = 0; e < 8; ++e) {
                    const float r1 = __int_as_float(__builtin_amdgcn_update_dpp(0, __float_as_int(g[e]), 0x121, 0xf, 0xf, false));
                    const float r2 = __int_as_float(__builtin_amdgcn_update_dpp(0, __float_as_int(g[e]), 0x122, 0xf, 0xf, false));
                    const float gm1 = (fr >= 1) ? r1 : p1[e];
                    const float gm2 = (fr >= 2) ? r2 : p2[e];
                    p1[e] = r1; p2[e] = r2;
                    o[e] = silu_f(w0[e] * gm2 + w1[e] * gm1 + w2[e] * g[e] + bb[e]) * v[e];
                }
                if (m > 0 || fr >= 2) {
                    u32x4 w; w.x = cvtpk(o[0], o[1]); w.y = cvtpk(o[2], o[3]); w.z = cvtpk(o[4], o[5]); w.w = cvtpk(o[6], o[7]);
                    *(u32x4*)(ACT + (size_t)r * FFN + cg0) = w;
                } else {
                    float* f = FIX + ((size_t)grp * 6 + fr) * FFN + cg0;
                    *(f32x4*)f = (f32x4){g[0], g[1], g[2], g[3]}; *(f32x4*)(f + 4) = (f32x4){g[4], g[5], g[6], g[7]};
                    float* fv = f + (size_t)2 * FFN;
                    *(f32x4*)fv = (f32x4){v[0], v[1], v[2], v[3]}; *(f32x4*)(fv + 4) = (f32x4){v[4], v[5], v[6], v[7]};
                }
                if (m == 3 && fr >= 14) {
                    float* f = FIX + ((size_t)grp * 6 + 4 + (fr - 14)) * FFN + cg0;
                    *(f32x4*)f = (f32x4){g[0], g[1], g[2], g[3]}; *(f32x4*)(f + 4) = (f32x4){g[4], g[5], g[6], g[7]};
                    float* co = nullptr;
                    if (r < MP) { if ((r & 4095) >= TP - 2) co = convp + ((size_t)(r >> 12) * 2 + ((r & 4095) - (TP - 2))) * FFN + cg0; }
                    else { const int rs = r - MP; if ((rs & 63) >= TS - 2) co = convs + ((size_t)(rs >> 6) * 2 + ((rs & 63) - (TS - 2))) * FFN + cg0; }
                    if (co) { *(f32x4*)co = (f32x4){g[0], g[1], g[2], g[3]}; *(f32x4*)(co + 4) = (f32x4){g[4], g[5], g[6], g[7]}; }
                }
            }
        }
    }
};
}

namespace att {
__device__ __forceinline__ int crow(int r, int hi) { return (r & 3) + 8 * (r >> 2) + 4 * hi; }
__device__ __forceinline__ s16x4 vtr(const LAS unsigned char* p) { return __builtin_bit_cast(s16x4, __builtin_amdgcn_ds_read_tr16_b64_v4i16((LAS v4i16_t*)p)); }
constexpr int BUFB = 20480, KREG = 12288, BT_OFF = 4 * BUFB, Q_OFF = BT_OFF + 1024;

struct Ptrs { const bf16_t* Q; int ldq; const bf16_t* K; int ldk; const bf16_t* Kr; const bf16_t* V; int ldv; };

__device__ __forceinline__ float xhalf_max(float m) { auto rr = __builtin_amdgcn_permlane32_swap(__float_as_uint(m), __float_as_uint(m), false, false); return fmaxf(__uint_as_float(rr[0]), __uint_as_float(rr[1])); }
__device__ __forceinline__ float xhalf_sum(float m) { auto rr = __builtin_amdgcn_permlane32_swap(__float_as_uint(m), __float_as_uint(m), false, false); return __uint_as_float(rr[0]) + __uint_as_float(rr[1]); }

__device__ __forceinline__ void softmax_def(f32x16& p0, f32x16& p1, bool first, float cb, float& mref, f32x16& negm, float& l, f32x16& oa, f32x16& ob) {
    float a = fmaxf(fmaxf(p0[0], p0[1]), p1[0]), b = fmaxf(fmaxf(p0[2], p0[3]), p1[1]);
    a = fmaxf(fmaxf(a, p1[2]), p1[3]);
#pragma unroll
    for (int r = 4; r < 16; r += 4) { a = fmaxf(fmaxf(a, p0[r]), p0[r + 1]); b = fmaxf(fmaxf(b, p0[r + 2]), p0[r + 3]); a = fmaxf(fmaxf(a, p1[r]), p1[r + 1]); b = fmaxf(fmaxf(b, p1[r + 2]), p1[r + 3]); }
    const float rm = xhalf_max(fmaxf(a, b));
    if (first || __any(rm > 16.f)) {
        const float dl = first ? rm : fmaxf(rm, 0.f);
        mref += dl;
#pragma unroll
        for (int r = 0; r < 16; ++r) { p0[r] -= dl; p1[r] -= dl; }
        const float nm = cb - mref;
#pragma unroll
        for (int r = 0; r < 16; ++r) negm[r] = nm;
        const float f = first ? 0.f : __builtin_amdgcn_exp2f(-dl);
        l *= f;
#pragma unroll
        for (int r = 0; r < 16; ++r) { oa[r] *= f; ob[r] *= f; }
    }
    float s0 = 0.f, s1 = 0.f, s2 = 0.f, s3 = 0.f;
#pragma unroll
    for (int r = 0; r < 16; ++r) { p0[r] = __builtin_amdgcn_exp2f(p0[r]); p1[r] = __builtin_amdgcn_exp2f(p1[r]); }
#pragma unroll
    for (int r = 0; r < 16; r += 2) { s0 += p0[r]; s1 += p0[r + 1]; s2 += p1[r]; s3 += p1[r + 1]; }
    l += (s0 + s1) + (s2 + s3);
}
__device__ __forceinline__ void pack_p(const f32x16& p0, const f32x16& p1, bf16x8 (&pa)[4]) {
    u32x4 w;
    w.x = cvtpk(p0[0], p0[1]); w.y = cvtpk(p0[2], p0[3]); w.z = cvtpk(p0[4], p0[5]); w.w = cvtpk(p0[6], p0[7]); pa[0] = __builtin_bit_cast(bf16x8, w);
    w.x = cvtpk(p0[8], p0[9]); w.y = cvtpk(p0[10], p0[11]); w.z = cvtpk(p0[12], p0[13]); w.w = cvtpk(p0[14], p0[15]); pa[1] = __builtin_bit_cast(bf16x8, w);
    w.x = cvtpk(p1[0], p1[1]); w.y = cvtpk(p1[2], p1[3]); w.z = cvtpk(p1[4], p1[5]); w.w = cvtpk(p1[6], p1[7]); pa[2] = __builtin_bit_cast(bf16x8, w);
    w.x = cvtpk(p1[8], p1[9]); w.y = cvtpk(p1[10], p1[11]); w.z = cvtpk(p1[12], p1[13]); w.w = cvtpk(p1[14], p1[15]); pa[3] = __builtin_bit_cast(bf16x8, w);
}

template <int MODE>
__device__ __forceinline__ void attn_unit(LAS unsigned char* lds, const Ptrs& P, int nq, int nt_block, int qpos0, bool sample, int h,
                                          const float* relb  , const float* lamp, const float* subg, bf16_t* Obase  , int wv) {
    const int tid = otid(wv);
    const int lane = tid & 63, r32 = lane & 31, hi = lane >> 5;
    const int wid = __builtin_amdgcn_readfirstlane(tid >> 6);
    const bool wact = (wid * 32 < nq);
    int ntw = sample ? nt_block : (((qpos0 + wid * 32) >> 6) + 1);
    if (!wact) ntw = 0;
    constexpr int NQF = (MODE == 0) ? 4 : 6;
    bf16x8 qf[NQF];
    {
        const int qr = wact ? (wid * 32 + r32) : 0;
        const bf16_t* qp = P.Q + (size_t)qr * P.ldq + hi * 8;
#pragma unroll
        for (int i = 0; i < NQF; ++i) qf[i] = *(const bf16x8*)(qp + i * 16);
    }
    LAS float* bt = (LAS float*)(lds + BT_OFF);
    float cbias = 0.f;
    if (MODE == 0) {
        if (tid < 256) {
            const int rel = tid - 192;
            const int n = rel < 0 ? -rel : rel;
            int bk = rel > 0 ? 16 : 0;
            if (n < 8) bk += n; else { int lg = 2 + (31 - __clz(n * n)); bk += (lg > 15 ? 15 : lg); }
            bt[tid] = relb[bk * 6 + h] * LOG2E;
        }
        cbias = relb[15 * 6 + h] * LOG2E;
    }
    const bf16_t* kg = P.K + (size_t)lane * P.ldk + wid * 8;
    const bf16_t* krg = (MODE == 1) ? (P.Kr + (size_t)lane * 32 + (wid & 3) * 8) : nullptr;
    const bf16_t* vg = P.V + (size_t)(16 * (wid & 3) + (lane >> 2)) * P.ldv + (wid >> 2) * 32 + (lane & 3) * 8;
    const int kdst = wid * 1024 + lane * 16, krdst = (8 + (wid & 3)) * 1024 + lane * 16, vdst = KREG + wid * 1024 + lane * 16;
    const int nst = (nt_block + 1) >> 1;
    u32x4 kreg[2], vreg[2], krreg[2];
#pragma unroll
    for (int j = 0; j < 2; ++j) {
        const int tt = (j < nt_block) ? j : (nt_block - 1);
        kreg[j] = *(const u32x4*)(kg + (size_t)tt * 64 * P.ldk); vreg[j] = *(const u32x4*)(vg + (size_t)tt * 64 * P.ldv);
        krreg[j] = (u32x4){0, 0, 0, 0};
        if (MODE == 1) { if (wid < 4) krreg[j] = *(const u32x4*)(krg + (size_t)tt * 64 * 32); }
    }
    float mr1 = 0.f, l1 = 0.f, mr2 = 0.f, l2 = 0.f;
    f32x16 o1a = {}, o1b = {}, o2a = {}, o2b = {};
    f32x16 ng1, ng2;
#pragma unroll
    for (int r = 0; r < 16; ++r) { ng1[r] = cbias; ng2[r] = cbias; }
    const int qmin = qpos0 + wid * 32, qposl = qmin + r32;
    const int vrd = ((lane >> 4) & 1) * 32 + (lane & 3) * 8 + (4 * hi + ((lane & 15) >> 2)) * 64;

    for (int st = 0; st < nst; ++st) {
        LAS unsigned char* sbuf = lds + (st & 1) * (2 * BUFB);
#pragma unroll
        for (int j = 0; j < 2; ++j) {
            *(LAS u32x4*)(sbuf + j * BUFB + kdst) = kreg[j];
            *(LAS u32x4*)(sbuf + j * BUFB + vdst) = vreg[j];
            if (MODE == 1) { if (wid < 4) *(LAS u32x4*)(sbuf + j * BUFB + krdst) = krreg[j]; }
        }
        __syncthreads();
        if (st + 1 < nst) {
#pragma unroll
            for (int j = 0; j < 2; ++j) {
                int tt = 2 * (st + 1) + j; tt = (tt < nt_block) ? tt : (nt_block - 1);
                kreg[j] = *(const u32x4*)(kg + (size_t)tt * 64 * P.ldk); vreg[j] = *(const u32x4*)(vg + (size_t)tt * 64 * P.ldv);
                if (MODE == 1) { if (wid < 4) krreg[j] = *(const u32x4*)(krg + (size_t)tt * 64 * 32); }
            }
        }
#pragma unroll 1
        for (int j = 0; j < 2; ++j) {
            const int t = 2 * st + j;
            if (t >= ntw) break;
            const LAS unsigned char* buf = sbuf + j * BUFB;
            const LAS unsigned char* kb = buf + hi * 1024 + r32 * 16;
            const LAS unsigned char* vp = buf + KREG + vrd;
            const bool first = (t == 0);
#define SB() __builtin_amdgcn_sched_barrier(0)
#define VLOADH(vf, h0) do { _Pragma("unroll") for (int ks = 2 * (h0); ks < 2 * (h0) + 2; ++ks) { \
                    const s16x4 lo0 = vtr(vp + ks * 1024), hi0 = vtr(vp + ks * 1024 + 512); \
                    const s16x4 lo1 = vtr(vp + 4096 + ks * 1024), hi1 = vtr(vp + 4096 + ks * 1024 + 512); \
                    vf[2 * ks] = (bf16x8){lo0[0], lo0[1], lo0[2], lo0[3], hi0[0], hi0[1], hi0[2], hi0[3]}; \
                    vf[2 * ks + 1] = (bf16x8){lo1[0], lo1[1], lo1[2], lo1[3], hi1[0], hi1[1], hi1[2], hi1[3]}; } } while (0)
#define VLOAD(vf) do { _Pragma("unroll") for (int ks = 0; ks < 4; ++ks) { \
                    const s16x4 lo0 = vtr(vp + ks * 1024), hi0 = vtr(vp + ks * 1024 + 512); \
                    const s16x4 lo1 = vtr(vp + 4096 + ks * 1024), hi1 = vtr(vp + 4096 + ks * 1024 + 512); \
                    vf[2 * ks] = (bf16x8){lo0[0], lo0[1], lo0[2], lo0[3], hi0[0], hi0[1], hi0[2], hi0[3]}; \
                    vf[2 * ks + 1] = (bf16x8){lo1[0], lo1[1], lo1[2], lo1[3], hi1[0], hi1[1], hi1[2], hi1[3]}; } } while (0)
            if (MODE == 1) {
                f32x16 p0, p1;
                bf16x8 kf[12];
#pragma unroll
                for (int ks = 0; ks < 6; ++ks) { kf[2 * ks] = *(const LAS bf16x8*)(kb + ks * 2048); kf[2 * ks + 1] = *(const LAS bf16x8*)(kb + ks * 2048 + 512); }
                SB();
                p0 = __builtin_amdgcn_mfma_f32_32x32x16_bf16(kf[0], qf[0], ng1, 0, 0, 0);
                p1 = __builtin_amdgcn_mfma_f32_32x32x16_bf16(kf[1], qf[0], ng1, 0, 0, 0);
#pragma unroll
                for (int ks = 1; ks < 6; ++ks) {
                    p0 = __builtin_amdgcn_mfma_f32_32x32x16_bf16(kf[2 * ks], qf[ks], p0, 0, 0, 0);
                    p1 = __builtin_amdgcn_mfma_f32_32x32x16_bf16(kf[2 * ks + 1], qf[ks], p1, 0, 0, 0);
                }
                bf16x8 vf[8]; VLOAD(vf);
                softmax_def(p0, p1, first, 0.f, mr1, ng1, l1, o1a, o1b);
                bf16x8 pa[4]; pack_p(p0, p1, pa);
#pragma unroll
                for (int ks = 0; ks < 4; ++ks) {
                    o1a = __builtin_amdgcn_mfma_f32_32x32x16_bf16(vf[2 * ks], pa[ks], o1a, 0, 0, 0);
                    o1b = __builtin_amdgcn_mfma_f32_32x32x16_bf16(vf[2 * ks + 1], pa[ks], o1b, 0, 0, 0);
                }
            } else {
                const int k0 = t * 64;
                const bool farT = (k0 + 63 - qmin <= -91);
                const int ib = k0 - qposl + 192 + 4 * hi;
                bf16x8 pa[4], pb[4];
                bf16x8 kf[4], kg2[4];
#pragma unroll
                for (int ks = 0; ks < 2; ++ks) { kf[2 * ks] = *(const LAS bf16x8*)(kb + ks * 2048); kf[2 * ks + 1] = *(const LAS bf16x8*)(kb + ks * 2048 + 512); }
                {
                    f32x16 p0, p1;
                    if (farT) {
                        p0 = __builtin_amdgcn_mfma_f32_32x32x16_bf16(kf[0], qf[0], ng1, 0, 0, 0);
                        p1 = __builtin_amdgcn_mfma_f32_32x32x16_bf16(kf[1], qf[0], ng1, 0, 0, 0);
                    } else {
                        const float nb = ng1[0] - cbias;
#pragma unroll
                        for (int r = 0; r < 16; ++r) { const int idx = ib + (r & 3) + 8 * (r >> 2); p0[r] = bt[idx] + nb; p1[r] = bt[idx + 32] + nb; }
                        p0 = __builtin_amdgcn_mfma_f32_32x32x16_bf16(kf[0], qf[0], p0, 0, 0, 0);
                        p1 = __builtin_amdgcn_mfma_f32_32x32x16_bf16(kf[1], qf[0], p1, 0, 0, 0);
                    }
                    p0 = __builtin_amdgcn_mfma_f32_32x32x16_bf16(kf[2], qf[1], p0, 0, 0, 0);
                    p1 = __builtin_amdgcn_mfma_f32_32x32x16_bf16(kf[3], qf[1], p1, 0, 0, 0);
#pragma unroll
                    for (int ks = 0; ks < 2; ++ks) { kg2[2 * ks] = *(const LAS bf16x8*)(kb + 4096 + ks * 2048); kg2[2 * ks + 1] = *(const LAS bf16x8*)(kb + 4096 + ks * 2048 + 512); }
                    softmax_def(p0, p1, first, cbias, mr1, ng1, l1, o1a, o1b);
                    pack_p(p0, p1, pa);
                }
                bf16x8 vf[8];
                {
                    f32x16 s0, s1;
                    if (farT) {
                        s0 = __builtin_amdgcn_mfma_f32_32x32x16_bf16(kg2[0], qf[2], ng2, 0, 0, 0);
                        s1 = __builtin_amdgcn_mfma_f32_32x32x16_bf16(kg2[1], qf[2], ng2, 0, 0, 0);
                    } else {
                        const float nb = ng2[0] - cbias;
#pragma unroll
                        for (int r = 0; r < 16; ++r) { const int idx = ib + (r & 3) + 8 * (r >> 2); s0[r] = bt[idx] + nb; s1[r] = bt[idx + 32] + nb; }
                        s0 = __builtin_amdgcn_mfma_f32_32x32x16_bf16(kg2[0], qf[2], s0, 0, 0, 0);
                        s1 = __builtin_amdgcn_mfma_f32_32x32x16_bf16(kg2[1], qf[2], s1, 0, 0, 0);
                    }
                    s0 = __builtin_amdgcn_mfma_f32_32x32x16_bf16(kg2[2], qf[3], s0, 0, 0, 0);
                    s1 = __builtin_amdgcn_mfma_f32_32x32x16_bf16(kg2[3], qf[3], s1, 0, 0, 0);
                    softmax_def(s0, s1, first, cbias, mr2, ng2, l2, o2a, o2b);
                    pack_p(s0, s1, pb);
                }
                VLOADH(vf, 0); VLOADH(vf, 1);
#pragma unroll
                for (int ks = 0; ks < 4; ++ks) {
                    o1a = __builtin_amdgcn_mfma_f32_32x32x16_bf16(vf[2 * ks], pa[ks], o1a, 0, 0, 0);
                    o1b = __builtin_amdgcn_mfma_f32_32x32x16_bf16(vf[2 * ks + 1], pa[ks], o1b, 0, 0, 0);
                    o2a = __builtin_amdgcn_mfma_f32_32x32x16_bf16(vf[2 * ks], pb[ks], o2a, 0, 0, 0);
                    o2b = __builtin_amdgcn_mfma_f32_32x32x16_bf16(vf[2 * ks + 1], pb[ks], o2b, 0, 0, 0);
                }
            }
#undef SB
#undef VLOAD
#undef VLOADH
        }
    }
    if (wact) {
        const float lt1 = xhalf_sum(l1);
        const float i1 = 1.f / lt1;
        bf16_t* orow = Obase + (size_t)(wid * 32 + r32) * 1024;
        if (MODE == 1) {
#pragma unroll
            for (int g = 0; g < 4; ++g) {
                u32x2 w; w.x = cvtpk(o1a[4 * g] * i1, o1a[4 * g + 1] * i1); w.y = cvtpk(o1a[4 * g + 2] * i1, o1a[4 * g + 3] * i1);
                *(u32x2*)(orow + 8 * g + 4 * hi) = w;
                w.x = cvtpk(o1b[4 * g] * i1, o1b[4 * g + 1] * i1); w.y = cvtpk(o1b[4 * g + 2] * i1, o1b[4 * g + 3] * i1);
                *(u32x2*)(orow + 32 + 8 * g + 4 * hi) = w;
            }
        } else {
            const float lt2 = xhalf_sum(l2);
            const float lam = lamp[0], lam_init = lamp[1];
            const float i2 = lam / lt2;
            float va[16], vb[16], ss = 0.f;
#pragma unroll
            for (int r = 0; r < 16; ++r) { va[r] = o1a[r] * i1 - o2a[r] * i2; vb[r] = o1b[r] * i1 - o2b[r] * i2; ss += va[r] * va[r] + vb[r] * vb[r]; }
            ss = xhalf_sum(ss);
            const float rs = rsqrtf(ss * (1.f / 64.f) + EPS) * (1.f - lam_init);
#pragma unroll
            for (int g = 0; g < 4; ++g) {
                const int d = 8 * g + 4 * hi;
                const f32x4 ga = *(const f32x4*)(subg + d), gb = *(const f32x4*)(subg + 32 + d);
                u32x2 w; w.x = cvtpk(va[4 * g] * rs * ga[0], va[4 * g + 1] * rs * ga[1]); w.y = cvtpk(va[4 * g + 2] * rs * ga[2], va[4 * g + 3] * rs * ga[3]);
                *(u32x2*)(orow + d) = w;
                w.x = cvtpk(vb[4 * g] * rs * gb[0], vb[4 * g + 1] * rs * gb[1]); w.y = cvtpk(vb[4 * g + 2] * rs * gb[2], vb[4 * g + 3] * rs * gb[3]);
                *(u32x2*)(orow + 32 + d) = w;
            }
        }
    }
    __syncthreads();
}
}

__device__ __forceinline__ void gemv24_item(LAS float* cs, LAS float* red, int tid, const float* W, int ldw, int srcn0, int nvalid, const float* bias, float scale, float* out, int ldo, int n0) {
    const int ks = tid >> 6, col = tid & 63;
    const float* w = W + srcn0 + col;
    float acc[24];
#pragma unroll
    for (int r = 0; r < 24; ++r) acc[r] = 0.f;
    if (col < nvalid) {
#pragma unroll 1
        for (int k = ks * 128; k < ks * 128 + 128; k += 8) {
            float wq[8];
#pragma unroll
            for (int j = 0; j < 8; ++j) wq[j] = w[(size_t)(k + j) * ldw];
#pragma unroll
            for (int j4 = 0; j4 < 2; ++j4)
#pragma unroll
                for (int r = 0; r < 24; ++r) { const f32x4 c4 = *(const LAS f32x4*)(cs + r * 1024 + k + 4 * j4); acc[r] += c4[0] * wq[4 * j4] + c4[1] * wq[4 * j4 + 1] + c4[2] * wq[4 * j4 + 2] + c4[3] * wq[4 * j4 + 3]; }
        }
    }
#pragma unroll
    for (int r = 0; r < 24; ++r) red[(ks * 24 + r) * 64 + col] = acc[r];
    __syncthreads();
    for (int i = tid; i < 24 * 64; i += NTHREADS) {
        const int r = i >> 6, c = i & 63; float sm = bias ? bias[n0 + c] : 0.f;
#pragma unroll
        for (int k8 = 0; k8 < 8; ++k8) sm += red[(k8 * 24 + r) * 64 + c];
        out[(size_t)r * ldo + n0 + c] = sm * scale;
    }
    __syncthreads();
}

__device__ __forceinline__ void shw_phase(const Args& a, LAS unsigned char* lds, int wv) {
    const int tid = otid(wv), G = gridDim.x, bx = blockIdx.x;
    LAS float* cs = (LAS float*)lds; LAS float* red = (LAS float*)(lds + 98304);
    for (int it = bx; it < 208; it += G) {
        int l, off, n0; const float* W; int ldw, srcn0, nvalid = 64; float* out; int ldo; float scale = 1.f;
        if (it < 176) {
            l = it / 88; n0 = (it % 88) * 64; off = 3072; W = a.in[28] + (size_t)l * 1024 * 5632; ldw = 5632;
            const int tile = n0 >> 8, within = n0 & 255; srcn0 = (within < 128) ? tile * 128 + within : FFN + tile * 128 + (within - 128);
            out = (float*)(a.ws + WS_SHW2) + (size_t)l * 24 * 5632; ldo = 5632;
        } else {
            l = 1; n0 = (it - 176) * 64; off = 0; W = a.in[13] + (size_t)l * 1024 * INC; ldw = INC; srcn0 = n0;
            nvalid = INC - n0; nvalid = nvalid < 0 ? 0 : (nvalid > 64 ? 64 : nvalid);
            out = (float*)(a.ws + WS_SHW1) + (size_t)l * 24 * INPAD; ldo = INPAD;
            if (n0 < 384) scale = 0.17677669529663687f * LOG2E;
        }
        const float* mod = (const float*)(a.ws + WS_MOD) + (size_t)l * 24 * 6144 + off;
        for (int i = tid; i < 24 * 1024; i += NTHREADS) cs[i] = mod[(size_t)(i >> 10) * 6144 + (i & 1023)];
        __syncthreads();
        gemv24_item(cs, red, tid, W, ldw, srcn0, nvalid, nullptr, scale, out, ldo, n0);
    }
}

__device__ __forceinline__ void prologue_phase(const Args& a, LAS unsigned char* lds, int wv) {
    unsigned char* ws = a.ws;
    const int tid = otid(wv), G = gridDim.x, bx = blockIdx.x;
    if (bx == 0) { unsigned* bw = (unsigned*)(ws + WS_BAR); for (int i = tid; i < XCD_BAR_WORDS; i += NTHREADS) bw[i] = 0u; }
    if (bx == 0 && tid < 64) {
        unsigned* ctl = (unsigned*)(ws + WS_CTL);
        if (tid < 32) ctl[tid] = 0u;
        if (tid < 16) ctl[48 + tid] = 0u;
        if (tid >= 32 && tid < 34) {
            const int l = tid - 32; float s1 = 0.f, s2 = 0.f;
            for (int i = 0; i < 32; ++i) { s1 += a.in[14][l * 32 + i] * a.in[15][l * 32 + i]; s2 += a.in[16][l * 32 + i] * a.in[17][l * 32 + i]; }
            const float li = 0.8f - 0.6f * expf(-0.3f * (float)l);
            float* lamv = (float*)(ws + WS_CTL + 256);
            lamv[l * 2] = expf(s1) - expf(s2) + li; lamv[l * 2 + 1] = li;
        }
    }
    {
        float* rope = (float*)(ws + WS_ROPE);
        for (int idx = bx * NTHREADS + tid; idx < TKS * 16; idx += G * NTHREADS) {
            const int pos = idx >> 4, i = idx & 15;
            const float angf = (float)pos * a.inv_freq[i];
            const double ang = (double)angf;
            const double nq = rint(ang * 0.63661977236758134308);
            const double rr = fma(-nq, 1.57079632679489661923, ang) - nq * 6.123233995736766e-17;
            const double r2 = rr * rr;
            const double sn = rr * (1.0 + r2 * (-1.0 / 6 + r2 * (1.0 / 120 + r2 * (-1.0 / 5040 + r2 * (1.0 / 362880 + r2 * (-1.0 / 39916800))))));
            const double cs = 1.0 + r2 * (-0.5 + r2 * (1.0 / 24 + r2 * (-1.0 / 720 + r2 * (1.0 / 40320 + r2 * (-1.0 / 3628800 + r2 * (1.0 / 479001600))))));
            const int q = (int)((long long)nq & 3);
            double c, s;
            if (q == 0) { c = cs; s = sn; } else if (q == 1) { c = -sn; s = cs; } else if (q == 2) { c = -cs; s = -sn; } else { c = sn; s = -cs; }
            rope[idx * 2] = (float)c; rope[idx * 2 + 1] = (float)s;
        }
    }
    {
        float* rsz = (float*)(ws + WS_RS);
        for (int i = bx * NTHREADS + tid; i < 3 * MT; i += G * NTHREADS) rsz[i] = 0.f;
    }
    {
        LAS float* cs = (LAS float*)lds;
        LAS float* red = (LAS float*)(lds + 98304);
        bool cs_ready = false;
        for (int it = bx; it < 192; it += G) {
            if (!cs_ready) {
                for (int i = tid; i < 24 * 1024; i += NTHREADS) { const int r = i >> 10, k = i & 1023; const float c = (r < 16) ? a.in[2][r * 1024 + k] : a.in[3][(r - 16) * 1024 + k]; cs[i] = c / (1.f + __expf(-c)); }
                cs_ready = true;
                __syncthreads();
            }
            const int l = it / 96, n0 = (it % 96) * 64;
            gemv24_item(cs, red, tid, a.in[10] + (size_t)l * 1024 * 6144, 6144, n0, 64, a.in[11] + l * 6144, 1.f, (float*)(ws + WS_MOD) + (size_t)l * 24 * 6144, 6144, n0);
        }
        __syncthreads();
    }
    {
        LAS float* tl = (LAS float*)lds;
        constexpr int NT_IN = 32 * 16, NT_Q = 12 * 4, NT_KV = 12 * 2, NT_O = 16 * 16, NT_UP = 88 * 16, NT_DN = 16 * 44;
        constexpr int NT_L = NT_IN + NT_Q + NT_KV + NT_O + NT_UP + NT_DN;
        constexpr int TPB = 22;
        const int n_main = (G == 256) ? TPB * 256 : 2 * NT_L;
        const int n_iter = (G == 256) ? ((bx < 192) ? TPB : TPB + (2 * NT_L - n_main + 63) / 64) : (2 * NT_L + G - 1) / G;
        for (int k = 0; k < n_iter; ++k) {
            int it;
            if (G == 256) it = (k < TPB) ? bx + k * 256 : n_main + (bx - 192) + (k - TPB) * 64; else it = bx + k * G;
            if (it >= 2 * NT_L) break;
            const int l = it / NT_L; int r = it % NT_L;
            const float* W; bf16_t* WT; int K, N, nkt; int mode = 0; float scale = 1.f; int scale_cols = 0;
            if (r < NT_IN) { W = a.in[13] + (size_t)l * 1024 * INC; WT = (bf16_t*)(ws + WS_WIN) + (size_t)l * INPAD * 1024; K = 1024; N = INC; scale = 0.17677669529663687f * LOG2E; scale_cols = 384; }
            else if ((r -= NT_IN) < NT_Q) { W = a.in[23] + (size_t)l * 256 * 576; WT = (bf16_t*)(ws + WS_WQUP) + (size_t)l * 768 * 256; K = 256; N = 576; scale = 0.10206207261596575f * LOG2E; scale_cols = 576; }
            else if ((r -= NT_Q) < NT_KV) { W = a.in[25] + (size_t)l * 128 * 768; WT = (bf16_t*)(ws + WS_WKV) + (size_t)l * 768 * 128; K = 128; N = 768; }
            else if ((r -= NT_KV) < NT_O) { W = a.in[26] + (size_t)l * 1024 * 1024; WT = (bf16_t*)(ws + WS_WOUT) + (size_t)l * 1024 * 1024; K = 1024; N = 1024; }
            else if ((r -= NT_O) < NT_UP) { W = a.in[28] + (size_t)l * 1024 * 5632; WT = (bf16_t*)(ws + WS_WUP) + (size_t)l * 5632 * 1024; K = 1024; N = 5632; mode = 1; }
            else { r -= NT_UP; W = a.in[31] + (size_t)l * FFN * 1024; WT = (bf16_t*)(ws + WS_WDN) + (size_t)l * 1024 * FFN; K = FFN; N = 1024; }
            nkt = K / 64;
            const int n0 = (r / nkt) * 64, k0 = (r % nkt) * 64;
            int srcn0 = n0;
            if (mode == 1) { const int tile = n0 >> 8, within = n0 & 255; srcn0 = (within < 128) ? tile * 128 + within : FFN + tile * 128 + (within - 128); }
            int nvalid = N - n0; nvalid = nvalid < 0 ? 0 : (nvalid > 64 ? 64 : nvalid);
            const float sc = (n0 < scale_cols) ? scale : 1.f;
#pragma unroll
            for (int i = 0; i < 8; ++i) {
                const int k = i * 8 + (tid >> 6), n = tid & 63;
                tl[k * 65 + n] = (n < nvalid) ? W[(size_t)(k0 + k) * N + srcn0 + n] * sc : 0.f;
            }
            __syncthreads();
            {
                const int n = tid >> 3, kc = (tid & 7) * 8;
                u32x4 w;
                w.x = cvtpk(tl[(kc + 0) * 65 + n], tl[(kc + 1) * 65 + n]); w.y = cvtpk(tl[(kc + 2) * 65 + n], tl[(kc + 3) * 65 + n]);
                w.z = cvtpk(tl[(kc + 4) * 65 + n], tl[(kc + 5) * 65 + n]); w.w = cvtpk(tl[(kc + 6) * 65 + n], tl[(kc + 7) * 65 + n]);
                *(u32x4*)(WT + (size_t)(n0 + n) * K + k0 + kc) = w;
            }
            __syncthreads();
        }
    }
}

__device__ __forceinline__ void norm_phase(const Args& a, int l, int which, bool from_input, int wv) {
    const int tid_ = otid(wv); const int lane = tid_ & 63, wid = tid_ >> 6;
    const float* g = a.in[which ? 27 : 12] + l * 1024;
    const float* mod = (const float*)(a.ws + WS_MOD) + (size_t)l * 24 * 6144;
    const int sh_off = which ? 3072 : 0, sc_off = which ? 4096 : 1024;
    bf16_t* H = (bf16_t*)(a.ws + WS_H);
    const float* xbuf = a.out;
    const int nw = gridDim.x * 8;
    for (int rb = blockIdx.x * 8 + wid; rb < MT; rb += nw * 4) {
        f32x4 v[4][4];
#pragma unroll
        for (int j = 0; j < 4; ++j) {
            const int row = rb + j * nw;
            if (row < MT) {
                const float* x = from_input ? ((row < MP) ? a.in[0] + (size_t)row * DM : a.in[1] + (size_t)(row - MP) * DM) : xbuf + (size_t)row * DM;
#pragma unroll
                for (int i = 0; i < 4; ++i) v[j][i] = from_input ? __builtin_nontemporal_load((const f32x4*)(x + i * 256 + lane * 4)) : *(const f32x4*)(x + i * 256 + lane * 4);
            }
        }
#pragma unroll
        for (int j = 0; j < 4; ++j) {
            const int row = rb + j * nw;
            if (row < MT) {
                const int b = batch_of(row);
                float ss = 0.f;
#pragma unroll
                for (int i = 0; i < 4; ++i) ss += v[j][i][0] * v[j][i][0] + v[j][i][1] * v[j][i][1] + v[j][i][2] * v[j][i][2] + v[j][i][3] * v[j][i][3];
                ss = wave_sum(ss);
                const float rstd = rsqrtf(ss * (1.f / 1024.f) + EPS);
                const float* mb = mod + (size_t)b * 6144;
#pragma unroll
                for (int i = 0; i < 4; ++i) {
                    const int c = i * 256 + lane * 4;
                    const f32x4 g4 = *(const f32x4*)(g + c), sc4 = *(const f32x4*)(mb + sc_off + c), sh4 = *(const f32x4*)(mb + sh_off + c);
                    f32x4 y;
#pragma unroll
                    for (int e = 0; e < 4; ++e) y[e] = v[j][i][e] * rstd * g4[e] * (1.f + sc4[e]) + sh4[e];
                    u32x2 w; w.x = cvtpk(y[0], y[1]); w.y = cvtpk(y[2], y[3]);
                    *(u32x2*)(H + (size_t)row * DM + c) = w;
                }
            }
        }
    }
}

__device__ __forceinline__ void post_phase(const Args& a, int l, int wv, int row_lo, int row_hi, int bidx, int nblk, bool do_cache) {
    unsigned char* ws = a.ws;
    const int tid_ = otid(wv); const int lane = tid_ & 63, wid = tid_ >> 6;
    const bf16_t* U = (const bf16_t*)(ws + WS_U);
    bf16_t* CQN = (bf16_t*)(ws + WS_CQN); bf16_t* LAT = (bf16_t*)(ws + WS_LAT); bf16_t* KR = (bf16_t*)(ws + WS_KR);
    bf16_t* KS = (bf16_t*)(ws + WS_KS); bf16_t* VS = (bf16_t*)(ws + WS_VS);
    const float* rope = (const float*)(ws + WS_ROPE);
    const float* gq = a.in[22] + l * 256; const float* gkv = a.in[24] + l * 128;
    float* latp = a.out + O_LATP + (size_t)l * MP * 128; float* lats = a.out + O_LATS + (size_t)l * MS * 128;
    float* krp = a.out + O_KRP + (size_t)l * MP * 32; float* krs = a.out + O_KRS + (size_t)l * MS * 32;
    const int nw = nblk * 8;
    const int MT = row_hi;
    for (int rb = row_lo + bidx * 8 + wid; rb < MT; rb += nw * 4) {
        u32x2 cqv[4]; unsigned ckvv[4]; unsigned short ckrv[4];
#pragma unroll
        for (int j = 0; j < 4; ++j) {
            const int row = rb + j * nw;
            cqv[j] = (u32x2){0u, 0u}; ckvv[j] = 0u; ckrv[j] = 0;
            if (row < MT) {
                const bf16_t* ur = U + (size_t)row * INC;
                cqv[j] = *(const u32x2*)(ur + 1408 + lane * 4); ckvv[j] = *(const unsigned*)(ur + 1664 + lane * 2); ckrv[j] = ur[1792 + (lane & 31)];
            }
        }
#pragma unroll
        for (int j = 0; j < 4; ++j) {
            const int row = rb + j * nw;
            if (row >= MT) continue;
            const bf16_t* ur = U + (size_t)row * INC;
            const size_t kvr = kvrow_of(row);
            {
                const u32x2 w = cqv[j];
                float x[4] = {bf2f((unsigned short)(w.x & 0xffff)), bf2f((unsigned short)(w.x >> 16)), bf2f((unsigned short)(w.y & 0xffff)), bf2f((unsigned short)(w.y >> 16))};
                float ss = wave_sum(x[0] * x[0] + x[1] * x[1] + x[2] * x[2] + x[3] * x[3]);
                const float rstd = rsqrtf(ss * (1.f / 256.f) + EPS);
                const f32x4 g4 = *(const f32x4*)(gq + lane * 4);
                u32x2 o; o.x = cvtpk(x[0] * rstd * g4[0], x[1] * rstd * g4[1]); o.y = cvtpk(x[2] * rstd * g4[2], x[3] * rstd * g4[3]);
                *(u32x2*)(CQN + (size_t)row * 256 + lane * 4) = o;
            }
            {
                const unsigned w = ckvv[j];
                const float x0 = bf2f((unsigned short)(w & 0xffff)), x1 = bf2f((unsigned short)(w >> 16));
                float ss = wave_sum(x0 * x0 + x1 * x1);
                const float rstd = rsqrtf(ss * (1.f / 128.f) + EPS);
                const float y0 = x0 * rstd * gkv[lane * 2], y1 = x1 * rstd * gkv[lane * 2 + 1];
                float* lo = (row < MP) ? latp + (size_t)row * 128 : lats + (size_t)(row - MP) * 128;
                __builtin_nontemporal_store((f32x2_t){y0, y1}, (f32x2_t*)(lo + lane * 2));
                *(unsigned*)(LAT + kvr * 128 + lane * 2) = cvtpk(y0, y1);
            }
            {
                const float x = bf2f(ckrv[j]);
                const float pv = __shfl_xor(x, 16);
                const int pos = pos_of(row);
                const int i = lane & 15;
                const float cs = rope[((size_t)pos * 16 + i) * 2], sn = rope[((size_t)pos * 16 + i) * 2 + 1];
                const float y = ((lane & 16) == 0) ? (x * cs - pv * sn) : (x * cs + pv * sn);
                const float yn = __shfl_down(y, 1);
                if (lane < 32) {
                    float* ko = (row < MP) ? krp + (size_t)row * 32 : krs + (size_t)(row - MP) * 32;
                    ko[lane] = y;
                    if ((lane & 1) == 0) *(unsigned*)(KR + kvr * 32 + lane) = cvtpk(y, yn);
                }
            }
            if (row >= MP) {
                const int rs = row - MP; const size_t dst = ((size_t)(rs >> 6) * TKS + PAST + (rs & 63)) * 384;
                if (lane < 48) { *(u32x4*)(KS + dst + lane * 8) = *(const u32x4*)(ur + 384 + lane * 8); *(u32x4*)(VS + dst + lane * 8) = *(const u32x4*)(ur + 768 + lane * 8); }
            }
        }
    }
    if (do_cache) {
        const size_t gtid = (size_t)bidx * NTHREADS + tid_, gsz = (size_t)nblk * NTHREADS;
        const float* ck = a.in[4] + (size_t)l * NBS * PAST * 384; const float* cv = a.in[5] + (size_t)l * NBS * PAST * 384;
        const size_t n1 = (size_t)NBS * PAST * 96;
        for (size_t i0 = gtid; i0 < n1; i0 += gsz * 4) {
            f32x4 k4[4], v4[4];
#pragma unroll
            for (int j = 0; j < 4; ++j) { const size_t i = i0 + j * gsz; if (i < n1) { const size_t rowi = i / 96; const int c = (int)(i % 96) * 4; k4[j] = __builtin_nontemporal_load((const f32x4*)(ck + rowi * 384 + c)); v4[j] = __builtin_nontemporal_load((const f32x4*)(cv + rowi * 384 + c)); } }
#pragma unroll
            for (int j = 0; j < 4; ++j) { const size_t i = i0 + j * gsz; if (i < n1) { const size_t rowi = i / 96; const int c = (int)(i % 96) * 4; const size_t b = rowi >> 12, t = rowi & 4095;
                const size_t d = (b * TKS + t) * 384 + c;
                u32x2 w; w.x = cvtpk(k4[j][0], k4[j][1]); w.y = cvtpk(k4[j][2], k4[j][3]); *(u32x2*)(KS + d) = w;
                w.x = cvtpk(v4[j][0], v4[j][1]); w.y = cvtpk(v4[j][2], v4[j][3]); *(u32x2*)(VS + d) = w; } }
        }
        const float* cl = a.in[6] + (size_t)l * NBS * PAST * 128;
        const size_t n2 = (size_t)NBS * PAST * 32;
        for (size_t i0 = gtid; i0 < n2; i0 += gsz * 4) {
            f32x4 x4[4];
#pragma unroll
            for (int j = 0; j < 4; ++j) { const size_t i = i0 + j * gsz; if (i < n2) x4[j] = __builtin_nontemporal_load((const f32x4*)(cl + i * 4)); }
#pragma unroll
            for (int j = 0; j < 4; ++j) { const size_t i = i0 + j * gsz; if (i < n2) { const size_t rowi = i / 32; const int c = (int)(i % 32) * 4; const size_t b = rowi >> 12, t = rowi & 4095;
                u32x2 w; w.x = cvtpk(x4[j][0], x4[j][1]); w.y = cvtpk(x4[j][2], x4[j][3]);
                *(u32x2*)(LAT + ((size_t)MP + b * TKS + t) * 128 + c) = w; } }
        }
        const float* cr = a.in[7] + (size_t)l * NBS * PAST * 32;
        const size_t n3 = (size_t)NBS * PAST * 8;
        for (size_t i = gtid; i < n3; i += gsz) {
            const size_t rowi = i / 8; const int c = (int)(i % 8) * 4; const size_t b = rowi >> 12, t = rowi & 4095;
            const f32x4 x4 = *(const f32x4*)(cr + rowi * 32 + c);
            u32x2 w; w.x = cvtpk(x4[0], x4[1]); w.y = cvtpk(x4[2], x4[3]);
            *(u32x2*)(KR + ((size_t)MP + b * TKS + t) * 32 + c) = w;
        }
    }
}

__device__ __forceinline__ void pool_unit(const Args& a, int l, int gi, LAS unsigned char* lds, int wv) {
    const int tid = otid(wv);
    LAS bf16_t* ext = (LAS bf16_t*)lds;
    LAS bf16_t* mb = (LAS bf16_t*)(lds + 40960);
    LAS bf16_t* wt = (LAS bf16_t*)(lds + 77824);
    const bf16_t* U = (const bf16_t*)(a.ws + WS_U);
    const int row0 = gi * 64;
    const bool smp = row0 >= MP;
    const int t0 = smp ? 0 : (row0 & 4095);
    u32x4 c[5];
#pragma unroll
    for (int k = 0; k < 5; ++k) {
        const int q = tid + k * NTHREADS; const int e = q >> 5, ch = q & 31;
        c[k] = (u32x4){0u, 0u, 0u, 0u};
        if (q < 79 * 32 && (e >= 15 || (!smp && t0 != 0))) c[k] = *(const u32x4*)(U + (size_t)(row0 + e - 15) * INC + 1152 + ch * 8);
    }
    f32x4 wq[8];
#pragma unroll
    for (int k = 0; k < 8; ++k) wq[k] = *(const f32x4*)(a.in[20] + (size_t)l * 4 * 4096 + (size_t)(tid + k * NTHREADS) * 4);
    f32x4 hs[2] = {{0.f, 0.f, 0.f, 0.f}, {0.f, 0.f, 0.f, 0.f}};
    if (smp) {
#pragma unroll
        for (int k = 0; k < 2; ++k) { const int idx = tid + k * NTHREADS; if (idx < 960) hs[k] = *(const f32x4*)(a.in[8] + (((size_t)l * NBS + ((row0 - MP) >> 6)) * 15) * 256 + (size_t)idx * 4); }
    }
#pragma unroll
    for (int k = 0; k < 5; ++k) {
        const int q = tid + k * NTHREADS; const int e = q >> 5, ch = q & 31;
        if (q < 79 * 32 && !(smp && e < 15)) *(LAS u32x4*)(ext + e * 256 + ch * 8) = c[k];
    }
    if (smp) {
#pragma unroll
        for (int k = 0; k < 2; ++k) { const int idx = tid + k * NTHREADS; if (idx < 960) { u32x2 o; o.x = cvtpk(hs[k][0], hs[k][1]); o.y = cvtpk(hs[k][2], hs[k][3]); *(LAS u32x2*)(ext + idx * 4) = o; } }
    }
#pragma unroll
    for (int k = 0; k < 8; ++k) {
        const int idx = tid + k * NTHREADS; const int g = idx >> 10, within = idx & 1023, c0 = within >> 4, d4 = (within & 15) * 4;
#pragma unroll
        for (int i2 = 0; i2 < 4; ++i2) wt[(g * 64 + d4 + i2) * 72 + c0] = (bf16_t)(cvtpk(wq[k][i2], 0.f) & 0xffff);
    }
    __syncthreads();
    {
        const int cc = tid & 63, tb = (tid >> 6) * 8;
#pragma unroll
        for (int g = 0; g < 4; ++g) {
            const int w = 2 << g, ch = g * 64 + cc;
            float S = 0.f;
            for (int j2 = 1; j2 < w; ++j2) S += bf2f(ext[(15 + tb - j2) * 256 + ch]);
#pragma unroll
            for (int jj = 0; jj < 8; ++jj) {
                const int t = tb + jj;
                const float cur = bf2f(ext[(15 + t) * 256 + ch]);
                S += cur;
                int cnt = w; if (!smp) { const int p = t0 + t + 1; cnt = p < w ? p : w; }
                mb[t * 288 + g * 72 + cc] = (bf16_t)(cvtpk(S / (float)cnt - cur, 0.f) & 0xffff);
                S -= bf2f(ext[(15 + t - w + 1) * 256 + ch]);
            }
        }
    }
    __syncthreads();
    {
        const int lane = tid & 63, wvi = tid >> 6, fr = lane & 15, fq = lane >> 4;
        bf16_t* MIX = (bf16_t*)(a.ws + WS_MIX);
#pragma unroll
        for (int i2 = 0; i2 < 8; ++i2) {
            const int T = wvi * 8 + i2; const int g = T >> 4, tm = (T >> 2) & 3, tn = T & 3;
            f32x4 acc = {0.f, 0.f, 0.f, 0.f};
#pragma unroll
            for (int ks = 0; ks < 2; ++ks) {
                const bf16x8 af = *(const LAS bf16x8*)(mb + (tm * 16 + fr) * 288 + g * 72 + ks * 32 + fq * 8);
                const bf16x8 bfr = *(const LAS bf16x8*)(wt + (g * 64 + tn * 16 + fr) * 72 + ks * 32 + fq * 8);
                acc = __builtin_amdgcn_mfma_f32_16x16x32_bf16(bfr, af, acc, 0, 0, 0);
            }
            const int d = g * 64 + tn * 16 + fq * 4;
            const f32x4 ps = *(const f32x4*)(a.in[21] + l * 256 + d);
            u32x2 o; o.x = cvtpk(acc[0] * ps[0], acc[1] * ps[1]); o.y = cvtpk(acc[2] * ps[2], acc[3] * ps[3]);
            *(u32x2*)(MIX + (size_t)(row0 + tm * 16 + fr) * 1024 + 384 + d) = o;
        }
    }
    __syncthreads();
}

__device__ __forceinline__ void attention_phase(const Args& a, int ci, int l, LAS unsigned char* lds, int wv) {
    unsigned char* ws = a.ws;
    unsigned* ctr = (unsigned*)(ws + WS_CTL) + ci * 8;
    const float* lamv = (const float*)(ws + WS_CTL + 256);
    const float* lamp = lamv + l * 2;
    const bf16_t* U = (const bf16_t*)(ws + WS_U); const bf16_t* QC = (const bf16_t*)(ws + WS_QC); const bf16_t* KVX = (const bf16_t*)(ws + WS_KVX);
    const bf16_t* KR = (const bf16_t*)(ws + WS_KR); const bf16_t* KS = (const bf16_t*)(ws + WS_KS); const bf16_t* VS = (const bf16_t*)(ws + WS_VS);
    bf16_t* MIX = (bf16_t*)(ws + WS_MIX);
    LAS unsigned* qw = (LAS unsigned*)(lds + att::Q_OFF);
    constexpr int QS = 12, QP = 384, QPOOL = NGRP / 8, QLEN = QS + QP + QPOOL;
    const int myx = (int)((unsigned)__builtin_amdgcn_s_getreg((3 << 11) | 20) & 7u);
    int vic = 0;
    for (;;) {
        const int x = (myx + vic) & 7;
        if (otid(wv) == 0) *qw = atomicAdd(ctr + x, 1u);
        __syncthreads();
        const int qi = (int)*qw;
        __syncthreads();
        if (qi >= QLEN) { if (++vic >= 8) break; continue; }
        if (qi < QS) {
            const int ui = x * QS + qi;
            const int type = ui / 48, b = (ui % 48) / 6, h = ui % 6;
            const int qrow0 = MP + b * 64;
            if (type == 0) {
                att::Ptrs P{U + (size_t)qrow0 * INC + h * 64, INC, KS + (size_t)b * TKS * 384 + h * 64, 384, nullptr, VS + (size_t)b * TKS * 384 + h * 64, 384};
                att::attn_unit<0>(lds, P, 64, 65, PAST, true, h, a.in[19], lamp, a.in[18] + l * 64, MIX + (size_t)qrow0 * 1024 + h * 64, wv);
            } else {
                const size_t kv0 = (size_t)MP + (size_t)b * TKS;
                att::Ptrs P{QC + (size_t)qrow0 * 576 + h * 96, 576, KVX + kv0 * 768 + h * 128, 768, KR + kv0 * 32, KVX + kv0 * 768 + h * 128 + 64, 768};
                att::attn_unit<1>(lds, P, 64, 65, PAST, true, h, nullptr, lamp, nullptr, MIX + (size_t)qrow0 * 1024 + 640 + h * 64, wv);
            }
        } else if (qi < QS + QP) {
            const int i2 = qi - QS; const int pr = i2 >> 5, within = i2 & 31; const int qb = 15 - (within >> 1);
            const int stream = x * 24 + pr * 2 + (within & 1);
            const int type = stream / 96, bh = stream % 96, b = bh / 6, h = bh % 6;
            const int qrow0 = b * 4096 + qb * 256; const size_t kv0 = (size_t)b * 4096;
            if (type == 0) {
                att::Ptrs P{U + (size_t)qrow0 * INC + h * 64, INC, U + kv0 * INC + 384 + h * 64, INC, nullptr, U + kv0 * INC + 768 + h * 64, INC};
                att::attn_unit<0>(lds, P, 256, 4 * (qb + 1), qb * 256, false, h, a.in[19], lamp, a.in[18] + l * 64, MIX + (size_t)qrow0 * 1024 + h * 64, wv);
            } else {
                att::Ptrs P{QC + (size_t)qrow0 * 576 + h * 96, 576, KVX + kv0 * 768 + h * 128, 768, KR + kv0 * 32, KVX + kv0 * 768 + h * 128 + 64, 768};
                att::attn_unit<1>(lds, P, 256, 4 * (qb + 1), qb * 256, false, h, nullptr, lamp, nullptr, MIX + (size_t)qrow0 * 1024 + 640 + h * 64, wv);
            }
        } else {
            const int i3 = (qi - QS - QP) * 8 + x;
            pool_unit(a, l, i3, lds, wv);
        }
    }
}

__device__ __forceinline__ void fix_phase(const Args& a, int l, int wv) {
    const float* FIX = (const float*)(a.ws + WS_FIX);
    bf16_t* ACT = (bf16_t*)(a.ws + WS_ACT);
    const float* cw = a.in[29] + (size_t)l * 3 * FFN; const float* cb = a.in[30] + (size_t)l * FFN;
    const size_t gtid = (size_t)blockIdx.x * NTHREADS + otid(wv), gsz = (size_t)gridDim.x * NTHREADS;
    for (size_t i = gtid; i < (size_t)NGRP * (FFN / 4); i += gsz) {
        const int gi = (int)(i / (FFN / 4)), c = (int)(i % (FFN / 4)) * 4;
        const float* f = FIX + (size_t)gi * 6 * FFN + c;
        f32x4 h0, h1;
        if (gi >= MP / 64) { const float* hs = a.in[9] + ((size_t)l * NBS + (gi - MP / 64)) * 2 * FFN + c; h0 = *(const f32x4*)hs; h1 = *(const f32x4*)(hs + FFN); }
        else if ((gi & 63) == 0) { h0 = (f32x4){0.f, 0.f, 0.f, 0.f}; h1 = h0; }
        else { const float* fp = f - (size_t)6 * FFN; h0 = *(const f32x4*)(fp + (size_t)4 * FFN); h1 = *(const f32x4*)(fp + (size_t)5 * FFN); }
        const f32x4 g0 = *(const f32x4*)f, g1 = *(const f32x4*)(f + FFN), v0 = *(const f32x4*)(f + (size_t)2 * FFN), v1 = *(const f32x4*)(f + (size_t)3 * FFN);
        const f32x4 w0 = *(const f32x4*)(cw + c), w1 = *(const f32x4*)(cw + FFN + c), w2 = *(const f32x4*)(cw + 2 * FFN + c), bb = *(const f32x4*)(cb + c);
        float o0[4], o1[4];
#pragma unroll
        for (int e = 0; e < 4; ++e) {
            o0[e] = pg8::silu_f(w0[e] * h0[e] + w1[e] * h1[e] + w2[e] * g0[e] + bb[e]) * v0[e];
            o1[e] = pg8::silu_f(w0[e] * h1[e] + w1[e] * g0[e] + w2[e] * g1[e] + bb[e]) * v1[e];
        }
        u32x2 w; w.x = cvtpk(o0[0], o0[1]); w.y = cvtpk(o0[2], o0[3]);
        *(u32x2*)(ACT + (size_t)gi * 64 * FFN + c) = w;
        w.x = cvtpk(o1[0], o1[1]); w.y = cvtpk(o1[2], o1[3]);
        *(u32x2*)(ACT + ((size_t)gi * 64 + 1) * FFN + c) = w;
    }
}

__device__ __forceinline__ void final_phase(const Args& a, int wv, int row_lo, int row_hi, int bidx, int nblk) {
    const int tid_ = otid(wv); const int lane = tid_ & 63, wid = tid_ >> 6;
    const float* g = a.in[32];
    const int nw = nblk * 8;
    const int MT = row_hi;
    for (int rb = row_lo + bidx * 8 + wid; rb < MT; rb += nw * 4) {
        f32x4 v[4][4];
#pragma unroll
        for (int j = 0; j < 4; ++j) {
            const int row = rb + j * nw;
            if (row < MT) {
                const float* x = a.out + (size_t)row * DM;
#pragma unroll
                for (int i = 0; i < 4; ++i) v[j][i] = *(const f32x4*)(x + i * 256 + lane * 4);
            }
        }
#pragma unroll
        for (int j = 0; j < 4; ++j) {
            const int row = rb + j * nw;
            if (row < MT) {
                float* x = a.out + (size_t)row * DM;
                float ss = 0.f;
#pragma unroll
                for (int i = 0; i < 4; ++i) ss += v[j][i][0] * v[j][i][0] + v[j][i][1] * v[j][i][1] + v[j][i][2] * v[j][i][2] + v[j][i][3] * v[j][i][3];
                ss = wave_sum(ss);
                const float rstd = rsqrtf(ss * (1.f / 1024.f) + EPS);
#pragma unroll
                for (int i = 0; i < 4; ++i) { const int c = i * 256 + lane * 4; const f32x4 g4 = *(const f32x4*)(g + c); __builtin_nontemporal_store(v[j][i] * rstd * g4, (f32x4*)(x + c)); }
            }
        }
    }
}

constexpr int N_PHASES = 22;
#ifndef SKIPMASK
#define SKIPMASK 0
#endif
#define EN(k) (!((SKIPMASK >> (k)) & 1))
#ifndef DUPMASK
#define DUPMASK 0
#endif
#define REPS(k) ((((DUPMASK) >> (k)) & 1) ? 2 : 1)
__global__ void __launch_bounds__(NTHREADS, 2) mega_fwd(Args a) {
    extern __shared__ __attribute__((aligned(16))) unsigned char lds_raw[];
    LAS unsigned char* lds = (LAS unsigned char*)lds_raw;
    cg::grid_group grid = cg::this_grid();
    const int wv = __builtin_amdgcn_readfirstlane((int)threadIdx.x >> 6);
    const int lo = a.ph_lo, hi = a.ph_hi;
    unsigned char* ws = a.ws;
    const int G = gridDim.x, bx = blockIdx.x;
#define IN(k) (lo <= (k) && (k) < hi)
#define SEAM(k) do { if (IN(k) && IN((k) + 1)) xcd_barrier(xbar); } while (0)
    if (IN(0) && EN(0)) { prologue_phase(a, lds, wv); }
    grid.sync();
    XcdBarrier xbar;
    {
        volatile LAS unsigned* st = (volatile LAS unsigned*)(lds + LDS_BARST);
        { const int t_ = otid(wv); if (t_ < 2) st[t_] = 0u; }
        __syncthreads();
        xbar = xcd_barrier_post((unsigned*)(ws + WS_BAR), st, wv);
    }
#pragma unroll 1
    for (int l = 0; l < 2; ++l) {
        const int pb = 1 + 10 * l;
        const float* mod = (const float*)(ws + WS_MOD) + (size_t)l * 24 * 6144;
        if (l == 0) {
            if (IN(pb + 0) && EN(1)) { shw_phase(a, lds, wv); norm_phase(a, 0, 0, true, wv); }
            SEAM(pb + 0);
        }
        _Pragma("unroll 1") for (int rep = 0; rep < REPS(2); ++rep) { if (rep) xcd_barrier(xbar);
        if (IN(pb + 1) && EN(2)) {
            pg8::Gemm g{(const bf16_t*)(ws + WS_H), (const bf16_t*)(ws + WS_WIN) + (size_t)l * INPAD * 1024, MT, INPAD, 1024};
            pg8::StaticOrder S; S.init((G == 256) ? MP : MT, INPAD, G, bx);
            pg8::EpiInProj E{(bf16_t*)(ws + WS_U), a.out + O_AKP + (size_t)l * MP * 384, a.out + O_AKS + (size_t)l * MS * 384, a.out + O_AVP + (size_t)l * MP * 384, a.out + O_AVS + (size_t)l * MS * 384,
                             a.out + O_POOLP + (size_t)l * NBP * 15 * 256, a.out + O_POOLS + (size_t)l * NBS * 15 * 256,
                             l ? (const float*)(ws + WS_RS) + (size_t)1 * MT : nullptr, (const float*)(ws + WS_SHW1) + (size_t)l * 24 * INPAD};
            pg8::gemm_phase(lds, g, S, E, wv);
        }
        }
        SEAM(pb + 1);
        _Pragma("unroll 1") for (int rep = 0; rep < REPS(3); ++rep) { if (rep) xcd_barrier(xbar);
        if (IN(pb + 2) && EN(3)) {
            unsigned* cnt1 = (unsigned*)(ws + WS_CTL) + 52 + l;
            if (G == 256 && bx >= 240) {
                const int si = bx - 240;
                if (rep == 0) {
                    pg8::Gemm g1{(const bf16_t*)(ws + WS_H), (const bf16_t*)(ws + WS_WIN) + (size_t)l * INPAD * 1024, MT, INPAD, 1024};
                    pg8::OneUnit S1{256 + (si >> 3), si & 7};
                    pg8::EpiInProj E1{(bf16_t*)(ws + WS_U), a.out + O_AKP + (size_t)l * MP * 384, a.out + O_AKS + (size_t)l * MS * 384, a.out + O_AVP + (size_t)l * MP * 384, a.out + O_AVS + (size_t)l * MS * 384,
                                      a.out + O_POOLP + (size_t)l * NBP * 15 * 256, a.out + O_POOLS + (size_t)l * NBS * 15 * 256,
                                      l ? (const float*)(ws + WS_RS) + (size_t)1 * MT : nullptr, (const float*)(ws + WS_SHW1) + (size_t)l * 24 * INPAD};
                    pg8::gemm_phase(lds, g1, S1, E1, wv);
                    publish_count(cnt1, otid(wv));
                }
                wait_count(cnt1, 16u);
                post_phase(a, l, wv, MP + si * 32, MP + si * 32 + 32, 0, 1, false);
            } else if (G == 256) {
                post_phase(a, l, wv, 0, MP, bx, 240, true);
            } else {
                post_phase(a, l, wv, 0, MT, bx, G, true);
            }
        }
        }
        SEAM(pb + 2);
        _Pragma("unroll 1") for (int rep = 0; rep < REPS(4); ++rep) { if (rep) xcd_barrier(xbar);
        if (IN(pb + 3) && EN(4)) {
            {
                pg8::Gemm g{(const bf16_t*)(ws + WS_CQN), (const bf16_t*)(ws + WS_WQUP) + (size_t)l * 768 * 256, MT, 768, 256};
                pg8::StaticOrder S; S.init(MT, 768, G, bx);
                pg8::EpiQup E{(bf16_t*)(ws + WS_QC), (const float*)(ws + WS_ROPE)};
                pg8::gemm_phase(lds, g, S, E, wv);
            }
            {
                pg8::Gemm g{(const bf16_t*)(ws + WS_LAT), (const bf16_t*)(ws + WS_WKV) + (size_t)l * 768 * 128, MKV, 768, 128};
                pg8::StaticOrder S; S.init(MKV, 768, G, bx);
                pg8::EpiBf16 E{(bf16_t*)(ws + WS_KVX), 768};
                pg8::gemm_phase(lds, g, S, E, wv);
            }
        }
        }
        SEAM(pb + 3);
        _Pragma("unroll 1") for (int rep = 0; rep < REPS(5); ++rep) { if (rep) xcd_barrier(xbar);
        if (IN(pb + 4) && EN(5)) { attention_phase(a, l + 2 * rep, l, lds, wv); }
        }
        SEAM(pb + 4);
        _Pragma("unroll 1") for (int rep = 0; rep < REPS(6); ++rep) { if (rep) xcd_barrier(xbar);
        if (IN(pb + 5) && EN(6)) {
            pg8::Gemm g{(const bf16_t*)(ws + WS_MIX), (const bf16_t*)(ws + WS_WOUT) + (size_t)l * 1024 * 1024, MT, 1024, 1024};
            pg8::StaticOrder S; S.init(MP, 1024, G, bx);
            pg8::EpiRes E{a.in[0], a.in[1], l == 0, a.out, rep ? (float*)(ws + WS_U) : a.out, mod + 2048,
                          rep ? nullptr : (bf16_t*)(ws + WS_H), a.in[27] + l * 1024, mod + 4096, (float*)(ws + WS_RS) + (size_t)(rep ? 3 : (l ? 2 : 0)) * MT};
            pg8::gemm_phase(lds, g, S, E, wv);
        }
        }
        SEAM(pb + 5);
        _Pragma("unroll 1") for (int rep = 0; rep < REPS(8); ++rep) { if (rep) xcd_barrier(xbar);
        if (IN(pb + 7) && EN(8)) {
            unsigned* cnt3 = (unsigned*)(ws + WS_CTL) + 48 + l;
            if (rep == 0 && bx >= 48 && bx < 112 && (bx & 7) == 0) {
                const int si = (bx - 48) >> 3;
                pg8::Gemm g3{(const bf16_t*)(ws + WS_MIX), (const bf16_t*)(ws + WS_WOUT) + (size_t)l * 1024 * 1024, MT, 1024, 1024};
                pg8::OneUnit S1{256 + (si >> 2), si & 3};
                pg8::EpiRes E3{a.in[0], a.in[1], l == 0, a.out, a.out, mod + 2048,
                               (bf16_t*)(ws + WS_H), a.in[27] + l * 1024, mod + 4096, (float*)(ws + WS_RS) + (size_t)(l ? 2 : 0) * MT};
                pg8::gemm_phase(lds, g3, S1, E3, wv);
                publish_count(cnt3, otid(wv));
            }
            pg8::Gemm g{(const bf16_t*)(ws + WS_H), (const bf16_t*)(ws + WS_WUP) + (size_t)l * 5632 * 1024, MT, 5632, 1024};
            pg8::GatedOrder S; S.so.init(MT, 5632, G, bx); S.cnt = cnt3; S.need = 8u; S.gate_pm = 256;
            pg8::EpiUp E{(bf16_t*)(ws + WS_ACT), (float*)(ws + WS_FIX), a.in[29] + (size_t)l * 3 * FFN, a.in[30] + (size_t)l * FFN,
                         a.out + O_CONVP + (size_t)l * NBP * 2 * FFN, a.out + O_CONVS + (size_t)l * NBS * 2 * FFN,
                         (const float*)(ws + WS_RS) + (size_t)(l ? 2 : 0) * MT, (const float*)(ws + WS_SHW2) + (size_t)l * 24 * 5632};
            pg8::gemm_phase(lds, g, S, E, wv);
        }
        }
        SEAM(pb + 7);
        _Pragma("unroll 1") for (int rep = 0; rep < REPS(9); ++rep) { if (rep) xcd_barrier(xbar);
        if (IN(pb + 8) && EN(9)) { fix_phase(a, l, wv); }
        }
        SEAM(pb + 8);
        _Pragma("unroll 1") for (int rep = 0; rep < REPS(10); ++rep) { if (rep) xcd_barrier(xbar);
        if (IN(pb + 9) && EN(10)) {
            pg8::Gemm g{(const bf16_t*)(ws + WS_ACT), (const bf16_t*)(ws + WS_WDN) + (size_t)l * 1024 * FFN, MT, 1024, FFN};
            pg8::StaticOrder S; S.init(l == 0 ? MT : MP, 1024, G, bx);
            pg8::EpiRes E{a.in[0], a.in[1], false, a.out, rep ? (float*)(ws + WS_LAT) : a.out, mod + 5120,
                          (l == 0 && !rep) ? (bf16_t*)(ws + WS_H) : nullptr, a.in[12] + 1024, mod + 24 * 6144 + 1024, (float*)(ws + WS_RS) + (size_t)(rep ? 3 : 1) * MT};
            pg8::gemm_phase(lds, g, S, E, wv);
        }
        }
        SEAM(pb + 9);
    }
#ifdef PROBE_SYNCS
    for (int i = 0; i < PROBE_SYNCS; ++i) xcd_barrier(xbar);
#endif
    if (IN(21) && EN(11)) {
        unsigned* cnt5 = (unsigned*)(ws + WS_CTL) + 50;
        if (G == 256 && bx >= 248) {
            const int si = bx - 248;
            const float* mod1 = (const float*)(ws + WS_MOD) + (size_t)24 * 6144;
            pg8::Gemm g5{(const bf16_t*)(ws + WS_ACT), (const bf16_t*)(ws + WS_WDN) + (size_t)1024 * FFN, MT, 1024, FFN};
            pg8::OneUnit S1{256 + (si >> 2), si & 3};
            pg8::EpiRes E5{a.in[0], a.in[1], false, a.out, a.out, mod1 + 5120, nullptr, a.in[12], mod1, (float*)(ws + WS_RS)};
            pg8::gemm_phase(lds, g5, S1, E5, wv);
            publish_count(cnt5, otid(wv));
            wait_count(cnt5, 8u);
            final_phase(a, wv, MP + si * 64, MP + si * 64 + 64, 0, 1);
        } else if (G == 256) {
            final_phase(a, wv, 0, MP, bx, 248);
        } else {
            final_phase(a, wv, 0, MT, bx, G);
        }
    }
#undef IN
#undef SEAM
}

extern "C" void kernel_launch(void* const* d_in, const int* in_sizes, int n_in, void* d_out, int out_size, void* d_ws, size_t ws_size, hipStream_t stream) {
    static int grid = 0;
    if (grid == 0) {
        if (n_in != 33 || (size_t)out_size != O_END || ws_size < WS_END) { fprintf(stderr, "kernel_launch: unexpected shapes: n_in %d out %d ws %zu (need %zu)\n", n_in, out_size, ws_size, (size_t)WS_END); grid = -1; return; }
        int dev = 0, cus = 0, per_cu = 0;
        hipGetDevice(&dev);
        hipDeviceGetAttribute(&cus, hipDeviceAttributeMultiprocessorCount, dev);
        if (hipFuncSetAttribute((const void*)mega_fwd, hipFuncAttributeMaxDynamicSharedMemorySize, LDS_BYTES) != hipSuccess) { fprintf(stderr, "kernel_launch: hipFuncSetAttribute failed\n"); grid = -1; return; }
        if (hipOccupancyMaxActiveBlocksPerMultiprocessor(&per_cu, (const void*)mega_fwd, NTHREADS, LDS_BYTES) != hipSuccess || per_cu < 1) { fprintf(stderr, "kernel_launch: occupancy query gave %d\n", per_cu); per_cu = 1; }
        (void)hipGetLastError();
        grid = cus * 1;
        if (grid <= 0) grid = 256;
    }
    if (grid < 0) return;
    Args a{};
    for (int i = 0; i < 33; ++i) a.in[i] = (const float*)d_in[i];
    a.out = (float*)d_out; a.ws = (unsigned char*)d_ws;
    for (int i = 0; i < 16; ++i) a.inv_freq[i] = 1.0f / powf(10000.0f, (float)i / 16.0f);
#if N_LAUNCH_MODE == 1
    a.ph_lo = 0; a.ph_hi = N_PHASES;
    void* args[] = {&a};
    hipError_t e = hipLaunchCooperativeKernel((const void*)mega_fwd, dim3(grid), dim3(NTHREADS), args, LDS_BYTES, stream);
    if (e != hipSuccess) fprintf(stderr, "cooperative launch failed: %s (grid %d)\n", hipGetErrorString(e), grid);
#else
    for (int p = 0; p < N_PHASES; ++p) {
        a.ph_lo = p; a.ph_hi = p + 1;
        hipLaunchKernelGGL(mega_fwd, dim3(grid), dim3(NTHREADS), LDS_BYTES, stream, a);
    }
#endif
}
```

```cpp
#include <hip/hip_runtime.h>
#include <hip/hip_cooperative_groups.h>
#include <cstdio>
#include <cstdint>
#include <cmath>
namespace cg = cooperative_groups;

#ifndef PG8_ALIGN_EPI
#define PG8_ALIGN_EPI 1
#endif
#ifndef N_LAUNCH_MODE
#define N_LAUNCH_MODE 1
#endif

#define LAS __attribute__((address_space(3)))
typedef unsigned short bf16_t;
typedef short bf16x8 __attribute__((ext_vector_type(8)));
typedef short s16x4 __attribute__((ext_vector_type(4)));
typedef float f32x4 __attribute__((ext_vector_type(4)));
typedef float f32x16 __attribute__((ext_vector_type(16)));
typedef unsigned u32x4 __attribute__((ext_vector_type(4)));
typedef unsigned u32x2 __attribute__((ext_vector_type(2)));
typedef float f32x2_t __attribute__((ext_vector_type(2)));
typedef __bf16 bf16x2_t __attribute__((ext_vector_type(2)));
typedef short v4i16_t __attribute__((ext_vector_type(4)));

constexpr int DM = 1024, NBP = 16, TP = 4096, NBS = 8, TS = 64, PAST = 4096;
constexpr int MP = NBP * TP, MS = NBS * TS, MT = MP + MS;
constexpr int TKS = PAST + TS;
constexpr int MKV = MP + NBS * TKS;
constexpr int INC = 1824, INPAD = 2048, FFN = 2816;
constexpr int NGRP = MT / 64;
constexpr float EPS = 1e-6f;
constexpr float LOG2E = 1.4426950408889634f;

constexpr size_t O_YP = 0;
constexpr size_t O_YS = O_YP + (size_t)MP * DM;
constexpr size_t O_AKP = O_YS + (size_t)MS * DM;
constexpr size_t O_AVP = O_AKP + (size_t)2 * MP * 384;
constexpr size_t O_LATP = O_AVP + (size_t)2 * MP * 384;
constexpr size_t O_KRP = O_LATP + (size_t)2 * MP * 128;
constexpr size_t O_POOLP = O_KRP + (size_t)2 * MP * 32;
constexpr size_t O_CONVP = O_POOLP + (size_t)2 * NBP * 15 * 256;
constexpr size_t O_AKS = O_CONVP + (size_t)2 * NBP * 2 * FFN;
constexpr size_t O_AVS = O_AKS + (size_t)2 * MS * 384;
constexpr size_t O_LATS = O_AVS + (size_t)2 * MS * 384;
constexpr size_t O_KRS = O_LATS + (size_t)2 * MS * 128;
constexpr size_t O_POOLS = O_KRS + (size_t)2 * MS * 32;
constexpr size_t O_CONVS = O_POOLS + (size_t)2 * NBS * 15 * 256;
constexpr size_t O_END = O_CONVS + (size_t)2 * NBS * 2 * FFN;

constexpr size_t al256(size_t x) { return (x + 255) & ~(size_t)255; }
constexpr size_t WS_CTL = 0;
constexpr size_t WS_BAR = 4096;
constexpr size_t WS_WIN = 32768;
constexpr size_t WS_WQUP = WS_WIN + (size_t)2 * INPAD * 1024 * 2;
constexpr size_t WS_WKV = WS_WQUP + (size_t)2 * 768 * 256 * 2;
constexpr size_t WS_WOUT = WS_WKV + (size_t)2 * 768 * 128 * 2;
constexpr size_t WS_WUP = WS_WOUT + (size_t)2 * 1024 * 1024 * 2;
constexpr size_t WS_WDN = WS_WUP + (size_t)2 * 5632 * 1024 * 2;
constexpr size_t WS_MOD = WS_WDN + (size_t)2 * 1024 * FFN * 2;
constexpr size_t WS_ROPE = WS_MOD + (size_t)2 * 24 * 6144 * 4;
constexpr size_t WS_RS = al256(WS_ROPE + (size_t)TKS * 16 * 2 * 4);
constexpr size_t WS_SHW1 = WS_RS + (size_t)4 * MT * 4;
constexpr size_t WS_SHW2 = WS_SHW1 + (size_t)2 * 24 * INPAD * 4;
constexpr size_t WS_H = al256(WS_SHW2 + (size_t)2 * 24 * 5632 * 4);
constexpr size_t WS_LAT = WS_H + (size_t)MT * 1024 * 2;
constexpr size_t WS_KR = WS_LAT + (size_t)MKV * 128 * 2;
constexpr size_t WS_KS = WS_KR + (size_t)MKV * 32 * 2;
constexpr size_t WS_VS = WS_KS + (size_t)NBS * TKS * 384 * 2;
constexpr size_t WS_MIX = WS_VS + (size_t)NBS * TKS * 384 * 2;
constexpr size_t WS_FIX = WS_MIX + (size_t)MT * 1024 * 2;
constexpr size_t WS_U = WS_FIX + (size_t)NGRP * 6 * FFN * 4;
constexpr size_t WS_CQN = WS_U + (size_t)MT * INC * 2;
constexpr size_t WS_QC = WS_CQN + (size_t)MT * 256 * 2;
constexpr size_t WS_KVX = WS_QC + (size_t)MT * 576 * 2;
constexpr size_t WS_END = WS_KVX + (size_t)MKV * 768 * 2;
constexpr size_t WS_ACT = WS_U;
static_assert(WS_ACT + (size_t)MT * FFN * 2 <= WS_END, "act overlay");
static_assert(WS_END <= (size_t)1073741824, "workspace");

constexpr int LDS_BYTES = 147456 + 64;
constexpr int LDS_BARST = 147456;
constexpr int NTHREADS = 512;

struct Args {
    const float* in[33];
    float* out; unsigned char* ws;
    float inv_freq[16];
    int ph_lo, ph_hi;
};

__device__ __forceinline__ int otid(int wv) { (void)wv; int t = threadIdx.x; asm volatile("" : "+v"(t)); return t; }
__device__ __forceinline__ unsigned cvtpk(float lo, float hi) { f32x2_t v = {lo, hi}; bf16x2_t b = __builtin_convertvector(v, bf16x2_t); return __builtin_bit_cast(unsigned, b); }
__device__ __forceinline__ float bf2f(unsigned short x) { return __uint_as_float((unsigned)x << 16); }
__device__ __forceinline__ float wave_sum(float v) {
#pragma unroll
    for (int o = 32; o >= 1; o >>= 1) v += __shfl_xor(v, o);
    return v;
}
__device__ __forceinline__ int batch_of(int row) { return row < MP ? (row >> 12) : 16 + ((row - MP) >> 6); }
__device__ __forceinline__ int pos_of(int row) { return row < MP ? (row & 4095) : PAST + ((row - MP) & 63); }
__device__ __forceinline__ size_t kvrow_of(int row) { return row < MP ? (size_t)row : (size_t)MP + (size_t)((row - MP) >> 6) * TKS + PAST + ((row - MP) & 63); }

#define XB_TMO      128
#define XB_XCNT(j)  (256  + 64 * (j))
#define XB_XSUB(j)  (1280 + 64 * (j))
#define XB_XGEN(j)  (2304 + 64 * (j))
#define XB_TOP      3328
#define XB_TOPGEN   3392
#define XCD_BAR_WORDS 3456
#define XB_SPIN_CAP (1u << 18)
__device__ __forceinline__ unsigned xb_ld(unsigned* p)              { return __hip_atomic_load(p, __ATOMIC_RELAXED, __HIP_MEMORY_SCOPE_AGENT); }
__device__ __forceinline__ unsigned xb_add(unsigned* p, unsigned v) { return __hip_atomic_fetch_add(p, v, __ATOMIC_RELAXED, __HIP_MEMORY_SCOPE_AGENT); }
__device__ __forceinline__ unsigned xb_xcc_id() { return (unsigned)__builtin_amdgcn_s_getreg((3 << 11) | 20) & 0xFu; }
#define XB_SPIN(cond, bar) do { unsigned _sp = 0; while (cond) { __builtin_amdgcn_s_sleep(1); \
    if ((++_sp & 255u) == 0u) { if (xb_ld(&(bar)[XB_TMO])) break; if (_sp > XB_SPIN_CAP) { atomicAdd(&(bar)[XB_TMO], 1u); break; } } } } while (0)
struct XcdBarrier { unsigned* bar; unsigned x; volatile LAS unsigned* st; int wv; };
__device__ __forceinline__ XcdBarrier xcd_barrier_post(unsigned* bar, volatile LAS unsigned* st, int wv) {
    XcdBarrier b; b.bar = bar; b.x = xb_xcc_id(); b.st = st; b.wv = wv;
    if (otid(wv) == 0) (void)xb_add(&bar[XB_XCNT(b.x)], 1u);
    return b;
}
__device__ __forceinline__ void xcd_barrier_complete(unsigned* bar, unsigned x, unsigned& nloc, unsigned& nx) {
    const unsigned G = gridDim.x * gridDim.y * gridDim.z;
    unsigned sum, cnt, mine, sp = 0u;
    for (;;) {
        sum = 0u; cnt = 0u; mine = 0u;
#pragma unroll
        for (unsigned j = 0; j < 16; ++j) { const unsigned c = xb_ld(&bar[XB_XCNT(j)]); sum += c; cnt += (c > 0u) ? 1u : 0u; mine = (j == x) ? c : mine; }
        if (sum == G) break;
        __builtin_amdgcn_s_sleep(1);
        if ((++sp & 255u) == 0u) { if (xb_ld(&bar[XB_TMO])) break; if (sp > XB_SPIN_CAP) { atomicAdd(&bar[XB_TMO], 1u); break; } }
    }
    nloc = mine > 0u ? mine : 1u; nx = cnt > 0u ? cnt : 1u;
}
__device__ __forceinline__ void xcd_barrier(const XcdBarrier& b) {
    asm volatile("s_waitcnt vmcnt(0)" ::: "memory");
    __syncthreads();
    if (otid(b.wv) == 0) {
        unsigned* bar = b.bar;
        __builtin_amdgcn_s_waitcnt(0);
        unsigned nloc = b.st[0], nx = b.st[1];
        if (nloc == 0u) { xcd_barrier_complete(bar, b.x, nloc, nx); b.st[0] = nloc; b.st[1] = nx; }
        const unsigned old = xb_add(&bar[XB_XSUB(b.x)], 1u);
        const unsigned gen = old / nloc;
        if (old + 1u == (gen + 1u) * nloc) {
            __builtin_amdgcn_fence(__ATOMIC_RELEASE, "agent");
            asm volatile("s_waitcnt vmcnt(0)" ::: "memory");
            const unsigned og = xb_add(&bar[XB_TOP], 1u);
            const unsigned tg = og / nx;
            if (og + 1u == (tg + 1u) * nx) xb_add(&bar[XB_TOPGEN], 1u);
            else XB_SPIN(xb_ld(&bar[XB_TOPGEN]) == tg, bar);
            __builtin_amdgcn_fence(__ATOMIC_ACQUIRE, "agent");
            xb_add(&bar[XB_XGEN(b.x)], 1u);
            asm volatile("s_waitcnt vmcnt(0)" ::: "memory");
        } else {
            XB_SPIN(xb_ld(&bar[XB_XGEN(b.x)]) == gen, bar);
            __builtin_amdgcn_fence(__ATOMIC_ACQUIRE, "agent");
            asm volatile("s_waitcnt vmcnt(0)" ::: "memory");
        }
    }
    __syncthreads();
}

__device__ __forceinline__ void publish_count(unsigned* cnt, int tid) {
    asm volatile("s_waitcnt vmcnt(0)" ::: "memory");
    __syncthreads();
    if (tid == 0) {
        __builtin_amdgcn_fence(__ATOMIC_RELEASE, "agent");
        asm volatile("s_waitcnt vmcnt(0)" ::: "memory");
        __hip_atomic_fetch_add(cnt, 1u, __ATOMIC_RELAXED, __HIP_MEMORY_SCOPE_AGENT);
    }
}
__device__ __forceinline__ void wait_count(unsigned* cnt, unsigned need) {
    unsigned sp = 0;
    while (__hip_atomic_load(cnt, __ATOMIC_RELAXED, __HIP_MEMORY_SCOPE_AGENT) < need) { __builtin_amdgcn_s_sleep(2); if (++sp > (1u << 22)) break; }
    __builtin_amdgcn_fence(__ATOMIC_ACQUIRE, "agent");
    asm volatile("s_waitcnt vmcnt(0)" ::: "memory");
}

namespace pg8 {
constexpr int BM = 256, BK = 64, HALF = 128, HTB = HALF * BK * 2, NXCD = 8, WGM = 8;
__host__ __device__ __forceinline__ int lds_byte(int r, int c) { const int st = (r >> 4) * 2 + (c >> 5), rr = r & 15, cc = c & 31, ob = rr * 64 + cc * 2; return st * 1024 + (ob ^ (((ob >> 9) & 1) << 5)); }
__host__ __device__ __forceinline__ void stage_rc(int b, int& R, int& C) { const int st = b / 1024, sb = b % 1024, swz = sb ^ (((sb >> 9) & 1) << 5); R = (st >> 1) * 16 + swz / 64; C = (st & 1) * 32 + (swz % 64) / 2; }
__host__ __device__ __forceinline__ int perm32(int rho) { const int n = rho >> 4, i = rho & 15; return 8 * (i >> 2) + 4 * n + (i & 3); }
struct Unit { int pm, pn; };
struct Gemm { const bf16_t* A; const bf16_t* Bt; int M, N, K; };
struct StaticOrder {
    int nM, nN, nwg, G, c;
    __device__ void init(int M, int N, int G_, int c_) { nM = M / BM; nN = N / BM; nwg = nM * nN; G = G_; c = c_; }
    __device__ bool next(int i, Unit& u) const {
        const long L = (long)i * G + c; if (L >= nwg) return false;
        int wgid = (int)L; { const int q = nwg / NXCD, r = nwg % NXCD, xcd = wgid % NXCD, off = wgid / NXCD; wgid = (xcd < r ? xcd * (q + 1) : r * (q + 1) + (xcd - r) * q) + off; }
        const int nig = WGM * nN, gid = wgid / nig, fm = gid * WGM, gsz = (nM - fm) < WGM ? (nM - fm) : WGM;
        u.pm = fm + ((wgid % nig) % gsz); u.pn = (wgid % nig) / gsz; return true;
    }
    __device__ __forceinline__ void a_ready(const Unit&) const {}
};
struct OneUnit {
    int pm, pn;
    __device__ bool next(int i, Unit& u) const { if (i != 0) return false; u.pm = pm; u.pn = pn; return true; }
    __device__ __forceinline__ void a_ready(const Unit&) const {}
};
struct GatedOrder {
    StaticOrder so; unsigned* cnt; unsigned need; int gate_pm;
    __device__ bool next(int i, Unit& u) const { return so.next(i, u); }
    __device__ __forceinline__ void a_ready(const Unit& u) const {
        if (u.pm >= gate_pm) {
            unsigned sp = 0;
            while (__hip_atomic_load(cnt, __ATOMIC_RELAXED, __HIP_MEMORY_SCOPE_AGENT) < need) { __builtin_amdgcn_s_sleep(2); if (++sp > (1u << 22)) break; }
            __builtin_amdgcn_fence(__ATOMIC_ACQUIRE, "agent");
            asm volatile("s_waitcnt vmcnt(0)" ::: "memory");
        }
    }
};
template <class Epi, class Sched>
__device__ __forceinline__ void gemm_phase(LAS unsigned char* lds, const Gemm g, const Sched& S, const Epi& E, int wv) {
    const int tid = otid(wv);
    const int wid = __builtin_amdgcn_readfirstlane(tid >> 6), lane = tid & 63, wr = wid >> 2, wc = wid & 3, fr = lane & 15, fq = lane >> 4;
    int K = g.K; asm volatile("" : "+s"(K));
    const int nt = K / BK;
    unsigned voffA[2], voffB[2];
#pragma unroll
    for (int i = 0; i < 2; ++i) { int R, C; stage_rc(tid * 16 + i * 8192, R, C); const int Rb = (R & ~31) + perm32(R & 31);
        voffA[i] = (unsigned)(R * K + C) * 2u; voffB[i] = (unsigned)(Rb * K + C) * 2u; }
    const size_t kstep = (size_t)(BK * 2);
    const size_t hstep = (size_t)HALF * K * 2;
    const size_t tstep = 2 * hstep;
    const unsigned ldsw = (unsigned)wid * 1024u;
    const int aoff = lds_byte(wr * 64 + fr, fq * 8), boff = lds_byte(wc * 32 + fr, fq * 8);
#define PG8_SA(b, h) (((b) * 2 + (h)) * HTB)
#define PG8_SB(b, h) ((4 + (b) * 2 + (h)) * HTB)
#define PG8_STAGE(bufoff, gbase, voff) do { _Pragma("unroll") for (int _i = 0; _i < 2; ++_i) \
        __builtin_amdgcn_global_load_lds((const unsigned*)((const char*)(gbase) + (voff)[_i]), (LAS unsigned*)(lds + (bufoff) + ldsw + _i * 8192), 16, 0, 0); } while (0)
#define PG8_LDA(dst, b, h) do { _Pragma("unroll") for (int m = 0; m < 4; ++m) _Pragma("unroll") for (int k = 0; k < 2; ++k) dst[m][k] = *(const LAS bf16x8*)(lds + PG8_SA(b, h) + aoff + m * 2048 + k * 1024); } while (0)
#define PG8_LDB(dst, b, h) do { _Pragma("unroll") for (int n = 0; n < 2; ++n) _Pragma("unroll") for (int k = 0; k < 2; ++k) dst[n][k] = *(const LAS bf16x8*)(lds + PG8_SB(b, h) + boff + n * 2048 + k * 1024); } while (0)
#define PG8_MMA(ai, bj, At, Bt) do { __builtin_amdgcn_s_setprio(1); _Pragma("unroll") for (int m = 0; m < 4; ++m) _Pragma("unroll") for (int n = 0; n < 2; ++n) _Pragma("unroll") for (int k = 0; k < 2; ++k) \
        acc[ai][bj][m][n] = __builtin_amdgcn_mfma_f32_16x16x32_bf16(Bt[n][k], At[m][k], acc[ai][bj][m][n], 0, 0, 0); __builtin_amdgcn_s_setprio(0); } while (0)
#define PG8_WAIT_V(n) asm volatile("s_waitcnt vmcnt(" #n ")" ::: "memory")
#define PG8_WAIT_L(n) asm volatile("s_waitcnt lgkmcnt(" #n ")" ::: "memory")
#define PG8_BAR __builtin_amdgcn_s_barrier()
#define PG8_SCHED __builtin_amdgcn_sched_barrier(0)
    Unit cur, nxt; int ui = 0;
    if (!S.next(0, cur)) return;
    f32x4 acc[2][2][4][2];
#pragma unroll
    for (int a = 0; a < 2; ++a)
#pragma unroll
        for (int b = 0; b < 2; ++b)
#pragma unroll
            for (int m = 0; m < 4; ++m)
#pragma unroll
                for (int n = 0; n < 2; ++n) acc[a][b][m][n] = (f32x4){0.f, 0.f, 0.f, 0.f};
    bf16x8 At[4][2], B0[2][2], B1[2][2];
    const char* cA = (const char*)g.A + (size_t)cur.pm * tstep; const char* cB = (const char*)g.Bt + (size_t)cur.pn * tstep;
    S.a_ready(cur);
    PG8_STAGE(PG8_SB(0, 0), cB, voffB); PG8_STAGE(PG8_SB(0, 1), cB + hstep, voffB); PG8_STAGE(PG8_SA(0, 0), cA, voffA); PG8_STAGE(PG8_SA(0, 1), cA + hstep, voffA);
    if (wr == 1) PG8_BAR;
    PG8_WAIT_V(2); PG8_BAR;
    PG8_STAGE(PG8_SB(1, 0), cB + kstep, voffB); PG8_STAGE(PG8_SA(1, 0), cA + kstep, voffA); PG8_STAGE(PG8_SB(1, 1), cB + hstep + kstep, voffB);
    PG8_WAIT_V(6); PG8_BAR;
    for (;;) {
        const bool has_next = S.next(ui + 1, nxt);
        const char* nA = has_next ? (const char*)g.A + (size_t)nxt.pm * tstep : cA; const char* nB = has_next ? (const char*)g.Bt + (size_t)nxt.pn * tstep : cB;
        for (int t = 0; t < nt; t += 2) {
            const bool last = (t == nt - 2);
            const char* a1 = cA + (size_t)(t + 1) * kstep;
            const char* a2 = last ? nA : cA + (size_t)(t + 2) * kstep; const char* b2 = last ? nB : cB + (size_t)(t + 2) * kstep;
            const char* a3 = a2 + kstep; const char* b3 = b2 + kstep;
            if (last && has_next) S.a_ready(nxt);
            PG8_LDB(B0, 0, 0); PG8_LDB(B1, 0, 1); PG8_SCHED; PG8_LDA(At, 0, 0); PG8_STAGE(PG8_SA(1, 1), a1 + hstep, voffA);
            PG8_WAIT_V(8); PG8_WAIT_L(0); PG8_BAR; PG8_MMA(0, 0, At, B0); PG8_MMA(0, 1, At, B1); PG8_BAR; PG8_SCHED;
            PG8_LDA(At, 0, 1); PG8_STAGE(PG8_SB(0, 0), b2, voffB); PG8_STAGE(PG8_SB(0, 1), b2 + hstep, voffB); PG8_STAGE(PG8_SA(0, 0), a2, voffA);
            PG8_WAIT_V(8); PG8_WAIT_L(0); PG8_BAR; PG8_MMA(1, 0, At, B0); PG8_MMA(1, 1, At, B1); PG8_BAR; PG8_SCHED;
            PG8_LDB(B0, 1, 0); PG8_LDB(B1, 1, 1); PG8_SCHED; PG8_LDA(At, 1, 0); PG8_STAGE(PG8_SA(0, 1), a2 + hstep, voffA);
            PG8_WAIT_V(8); PG8_WAIT_L(0); PG8_BAR; PG8_MMA(0, 0, At, B0); PG8_MMA(0, 1, At, B1); PG8_BAR; PG8_SCHED;
            PG8_LDA(At, 1, 1); PG8_STAGE(PG8_SB(1, 0), b3, voffB); PG8_STAGE(PG8_SB(1, 1), b3 + hstep, voffB); PG8_STAGE(PG8_SA(1, 0), a3, voffA);
            PG8_WAIT_V(8); PG8_WAIT_L(0); PG8_BAR; PG8_MMA(1, 0, At, B0); PG8_MMA(1, 1, At, B1); PG8_BAR; PG8_SCHED;
        }
#if PG8_ALIGN_EPI
        if (wr == 0) PG8_BAR;
#endif
        E(acc, cur, wr, wc, fr, fq);
        if (!has_next) break;
#pragma unroll
        for (int a = 0; a < 2; ++a)
#pragma unroll
            for (int b = 0; b < 2; ++b)
#pragma unroll
                for (int m = 0; m < 4; ++m)
#pragma unroll
                    for (int n = 0; n < 2; ++n) acc[a][b][m][n] = (f32x4){0.f, 0.f, 0.f, 0.f};
        cur = nxt; cA = nA; cB = nB; ++ui;
#if PG8_ALIGN_EPI
        if (wr == 1) PG8_BAR;
#endif
    }
    PG8_WAIT_V(0);
#if !PG8_ALIGN_EPI
    if (wr == 0) PG8_BAR;
#endif
    PG8_BAR;
#undef PG8_SA
#undef PG8_SB
#undef PG8_STAGE
#undef PG8_LDA
#undef PG8_LDB
#undef PG8_MMA
#undef PG8_WAIT_V
#undef PG8_WAIT_L
#undef PG8_BAR
#undef PG8_SCHED
}

#define EPI_ROW(u, ai, wr, m, fr) ((u).pm * 256 + (ai) * 128 + (wr) * 64 + (m) * 16 + (fr))

struct EpiInProj {
    bf16_t* U; float* akp; float* aks; float* avp; float* avs; float* poolp; float* pools;
    const float* rs; const float* shw;
    __device__ __forceinline__ void operator()(const f32x4 (&acc)[2][2][4][2], const Unit& u, int wr, int wc, int fr, int fq) const {
#pragma unroll
        for (int bj = 0; bj < 2; ++bj) {
            const int c0 = u.pn * 256 + bj * 128 + wc * 32 + 8 * fq;
            if (c0 >= INC) continue;
#pragma unroll
            for (int ai = 0; ai < 2; ++ai)
#pragma unroll
                for (int m = 0; m < 4; ++m) {
                    const int r = EPI_ROW(u, ai, wr, m, fr);
                    f32x4 v0 = acc[ai][bj][m][0], v1 = acc[ai][bj][m][1];
                    if (rs) {
                        const float rstd = rsqrtf(rs[r] * (1.f / 1024.f) + EPS);
                        const float* sp = shw + (size_t)batch_of(r) * INPAD + c0;
                        v0 = v0 * rstd + *(const f32x4*)sp; v1 = v1 * rstd + *(const f32x4*)(sp + 4);
                    }
                    u32x4 w; w.x = cvtpk(v0[0], v0[1]); w.y = cvtpk(v0[2], v0[3]); w.z = cvtpk(v1[0], v1[1]); w.w = cvtpk(v1[2], v1[3]);
                    *(u32x4*)(U + (size_t)r * INC + c0) = w;
                    if (c0 >= 384 && c0 < 768) {
                        float* o = (r < MP) ? akp + (size_t)r * 384 : aks + (size_t)(r - MP) * 384; o += c0 - 384;
                        __builtin_nontemporal_store(v0, (f32x4*)o); __builtin_nontemporal_store(v1, (f32x4*)(o + 4));
                    } else if (c0 >= 768 && c0 < 1152) {
                        float* o = (r < MP) ? avp + (size_t)r * 384 : avs + (size_t)(r - MP) * 384; o += c0 - 768;
                        __builtin_nontemporal_store(v0, (f32x4*)o); __builtin_nontemporal_store(v1, (f32x4*)(o + 4));
                    } else if (c0 >= 1152 && c0 < 1408) {
                        if (r < MP) { const int t = r & 4095; if (t >= TP - 15) { float* o = poolp + ((size_t)(r >> 12) * 15 + (t - (TP - 15))) * 256 + (c0 - 1152); *(f32x4*)o = v0; *(f32x4*)(o + 4) = v1; } }
                        else { const int rs = r - MP, t = rs & 63; if (t >= TS - 15) { float* o = pools + ((size_t)(rs >> 6) * 15 + (t - (TS - 15))) * 256 + (c0 - 1152); *(f32x4*)o = v0; *(f32x4*)(o + 4) = v1; } }
                    }
                }
        }
    }
};

struct EpiQup {
    bf16_t* QC; const float* rope;
    __device__ __forceinline__ void operator()(const f32x4 (&acc)[2][2][4][2], const Unit& u, int wr, int wc, int fr, int fq) const {
#pragma unroll
        for (int bj = 0; bj < 2; ++bj) {
            const int cb = u.pn * 256 + bj * 128 + wc * 32;
            if (cb >= 576) continue;
            const int c0 = cb + 8 * fq;
            const bool isrope = (cb % 96) == 64;
#pragma unroll
            for (int ai = 0; ai < 2; ++ai)
#pragma unroll
                for (int m = 0; m < 4; ++m) {
                    const int r = EPI_ROW(u, ai, wr, m, fr);
                    float v[8];
#pragma unroll
                    for (int e = 0; e < 4; ++e) { v[e] = acc[ai][bj][m][0][e]; v[4 + e] = acc[ai][bj][m][1][e]; }
                    if (isrope) {
                        const int pos = pos_of(r);
                        const int i0 = (8 * fq) & 15;
                        const float* rp = rope + ((size_t)pos * 16 + i0) * 2;
                        const float sg = (fq < 2) ? -1.f : 1.f;
#pragma unroll
                        for (int e2 = 0; e2 < 4; ++e2) {
                            const f32x4 t4 = *(const f32x4*)(rp + 4 * e2);
                            const float pv0 = __shfl_xor(v[2 * e2], 32), pv1 = __shfl_xor(v[2 * e2 + 1], 32);
                            v[2 * e2] = v[2 * e2] * t4[0] + sg * pv0 * t4[1];
                            v[2 * e2 + 1] = v[2 * e2 + 1] * t4[2] + sg * pv1 * t4[3];
                        }
                    }
                    u32x4 w; w.x = cvtpk(v[0], v[1]); w.y = cvtpk(v[2], v[3]); w.z = cvtpk(v[4], v[5]); w.w = cvtpk(v[6], v[7]);
                    *(u32x4*)(QC + (size_t)r * 576 + c0) = w;
                }
        }
    }
};

struct EpiBf16 {
    bf16_t* O; int ldc;
    __device__ __forceinline__ void operator()(const f32x4 (&acc)[2][2][4][2], const Unit& u, int wr, int wc, int fr, int fq) const {
#pragma unroll
        for (int bj = 0; bj < 2; ++bj) {
            const int c0 = u.pn * 256 + bj * 128 + wc * 32 + 8 * fq;
#pragma unroll
            for (int ai = 0; ai < 2; ++ai)
#pragma unroll
                for (int m = 0; m < 4; ++m) {
                    const int r = EPI_ROW(u, ai, wr, m, fr);
                    const f32x4 v0 = acc[ai][bj][m][0], v1 = acc[ai][bj][m][1];
                    u32x4 w; w.x = cvtpk(v0[0], v0[1]); w.y = cvtpk(v0[2], v0[3]); w.z = cvtpk(v1[0], v1[1]); w.w = cvtpk(v1[2], v1[3]);
                    *(u32x4*)(O + (size_t)r * ldc + c0) = w;
                }
        }
    }
};

struct EpiRes {
    const float* xp; const float* xs; bool from_input; const float* xbuf; float* xdst; const float* gate;
    bf16_t* Hn; const float* gn; const float* scn; float* rsn;
    __device__ __forceinline__ void operator()(const f32x4 (&acc)[2][2][4][2], const Unit& u, int wr, int wc, int fr, int fq) const {
        const int c00 = u.pn * 256 + wc * 32 + 8 * fq;
#pragma unroll
        for (int ai = 0; ai < 2; ++ai) {
            const int rbase = u.pm * 256 + ai * 128 + wr * 64 + fr;
            const int b = batch_of(rbase);
            f32x4 gt[2][2], gh[2][2];
#pragma unroll
            for (int bj = 0; bj < 2; ++bj) {
                const int c0 = c00 + bj * 128;
                const float* gp = gate + (size_t)b * 6144 + c0;
                gt[bj][0] = *(const f32x4*)gp; gt[bj][1] = *(const f32x4*)(gp + 4);
                if (Hn) {
                    const float* sp = scn + (size_t)b * 6144 + c0;
                    gh[bj][0] = *(const f32x4*)(gn + c0) * (*(const f32x4*)sp + 1.f); gh[bj][1] = *(const f32x4*)(gn + c0 + 4) * (*(const f32x4*)(sp + 4) + 1.f);
                }
            }
#pragma unroll
            for (int mp = 0; mp < 2; ++mp) {
                f32x4 xv[2][2][2];
#pragma unroll
                for (int m2 = 0; m2 < 2; ++m2) {
                    const int r = rbase + 16 * (2 * mp + m2);
                    const float* xo = from_input ? ((r < MP) ? xp + (size_t)r * DM : xs + (size_t)(r - MP) * DM) : xbuf + (size_t)r * DM;
#pragma unroll
                    for (int bj = 0; bj < 2; ++bj) { xv[m2][bj][0] = *(const f32x4*)(xo + c00 + bj * 128); xv[m2][bj][1] = *(const f32x4*)(xo + c00 + bj * 128 + 4); }
                }
#pragma unroll
                for (int m2 = 0; m2 < 2; ++m2) {
                    const int m = 2 * mp + m2;
                    const int r = rbase + 16 * m;
                    float ss = 0.f;
#pragma unroll
                    for (int bj = 0; bj < 2; ++bj) {
                        const int c0 = c00 + bj * 128;
                        float* xn = xdst + (size_t)r * DM + c0;
                        const f32x4 y0 = xv[m2][bj][0] + gt[bj][0] * acc[ai][bj][m][0], y1 = xv[m2][bj][1] + gt[bj][1] * acc[ai][bj][m][1];
                        *(f32x4*)xn = y0; *(f32x4*)(xn + 4) = y1;
                        if (Hn) {
                            ss += y0[0] * y0[0] + y0[1] * y0[1] + y0[2] * y0[2] + y0[3] * y0[3] + y1[0] * y1[0] + y1[1] * y1[1] + y1[2] * y1[2] + y1[3] * y1[3];
                            const f32x4 h0 = y0 * gh[bj][0], h1 = y1 * gh[bj][1];
                            u32x4 w; w.x = cvtpk(h0[0], h0[1]); w.y = cvtpk(h0[2], h0[3]); w.z = cvtpk(h1[0], h1[1]); w.w = cvtpk(h1[2], h1[3]);
                            *(u32x4*)(Hn + (size_t)r * DM + c0) = w;
                        }
                    }
                    if (Hn) {
                        ss += __shfl_xor(ss, 16); ss += __shfl_xor(ss, 32);
                        if (fq == 0) atomicAdd(rsn + r, ss);
                    }
                }
            }
            __builtin_amdgcn_sched_barrier(0);
        }
    }
};

__device__ __forceinline__ float silu_f(float x) { return x * __builtin_amdgcn_rcpf(1.f + __expf(-x)); }
struct EpiUp {
    bf16_t* ACT; float* FIX; const float* cw; const float* cb; float* convp; float* convs;
    const float* rs; const float* shw;
    __device__ __forceinline__ void operator()(const f32x4 (&acc)[2][2][4][2], const Unit& u, int wr, int wc, int fr, int fq) const {
        const int cg0 = u.pn * 128 + wc * 32 + 8 * fq;
        const int cn0 = u.pn * 256 + wc * 32 + 8 * fq;
        float w0[8], w1[8], w2[8], bb[8];
#pragma unroll
        for (int e = 0; e < 8; ++e) { w0[e] = cw[cg0 + e]; w1[e] = cw[FFN + cg0 + e]; w2[e] = cw[2 * FFN + cg0 + e]; bb[e] = cb[cg0 + e]; }
#pragma unroll
        for (int ai = 0; ai < 2; ++ai) {
            const int grp = (u.pm * 256 + ai * 128 + wr * 64) >> 6;
            float sg[8], sv[8];
            {
                const float* sp = shw + (size_t)batch_of(grp * 64) * 5632 + cn0;
#pragma unroll
                for (int e = 0; e < 8; ++e) { sg[e] = sp[e]; sv[e] = sp[128 + e]; }
            }
            float p1[8], p2[8];
#pragma unroll
            for (int e = 0; e < 8; ++e) { p1[e] = 0.f; p2[e] = 0.f; }
#pragma unroll
            for (int m = 0; m < 4; ++m) {
                const int r = EPI_ROW(u, ai, wr, m, fr);
                float g[8], v[8], o[8];
#pragma unroll
                for (int e = 0; e < 4; ++e) { g[e] = acc[ai][0][m][0][e]; g[4 + e] = acc[ai][0][m][1][e]; v[e] = acc[ai][1][m][0][e]; v[4 + e] = acc[ai][1][m][1][e]; }
                {
                    const float rstd = rsqrtf(rs[r] * (1.f / 1024.f) + EPS);
#pragma unroll
                    for (int e = 0; e < 8; ++e) { g[e] = g[e] * rstd + sg[e]; v[e] = v[e] * rstd + sv[e]; }
                }
#pragma unroll
                for (int e = 0; e < 8; ++e) {
                    const float r1 = __int_as_float(__builtin_amdgcn_update_dpp(0, __float_as_int(g[e]), 0x121, 0xf, 0xf, false));
                    const float r2 = __int_as_float(__builtin_amdgcn_update_dpp(0, __float_as_int(g[e]), 0x122, 0xf, 0xf, false));
                    const float gm1 = (fr >= 1) ? r1 : p1[e];
                    const float gm2 = (fr >= 2) ? r2 : p2[e];
                    p1[e] = r1; p2[e] = r2;
                    o[e] = silu_f(w0[e] * gm2 + w1[e] * gm1 + w2[e] * g[e] + bb[e]) * v[e];
                }
                if (m > 0 || fr >= 2) {
                    u32x4 w; w.x = cvtpk(o[0], o[1]); w.y = cvtpk(o[2], o[3]); w.z = cvtpk(o[4], o[5]); w.w = cvtpk(o[6], o[7]);
                    *(u32x4*)(ACT + (size_t)r * FFN + cg0) = w;
                } else {
                    float* f = FIX + ((size_t)grp * 6 + fr) * FFN + cg0;
                    *(f32x4*)f = (f32x4){g[0], g[1], g[2], g[3]}; *(f32x4*)(f + 4) = (f32x4){g[4], g[5], g[6], g[7]};
                    float* fv = f + (size_t)2 * FFN;
                    *(f32x4*)fv = (f32x4){v[0], v[1], v[2], v[3]}; *(f32x4*)(fv + 4) = (f32x4){v[4], v[5], v[6], v[7]};
                }
                if (m == 3 && fr >= 14) {
                    float* f = FIX + ((size_t)grp * 6 + 4 + (fr - 14)) * FFN + cg0;
                    *(f32x4*)f = (f32x4){g[0], g[1], g[2], g[3]}; *(f32x4*)(f + 4) = (f32x4){g[4], g[5], g[6], g[7]};
                    float* co = nullptr;
                    if (r < MP) { if ((r & 4095) >= TP - 2) co = convp + ((size_t)(r >> 12) * 2 + ((r & 4095) - (TP - 2))) * FFN + cg0; }
                    else { const int rs = r - MP; if ((rs & 63) >= TS - 2) co = convs + ((size_t)(rs >> 6) * 2 + ((rs & 63) - (TS - 2))) * FFN + cg0; }
                    if (co) { *(f32x4*)co = (f32x4){g[0], g[1], g[2], g[3]}; *(f32x4*)(co + 4) = (f32x4){g[4], g[5], g[6], g[7]}; }
                }
            }
        }
    }
};
}

namespace att {
__device__ __forceinline__ int crow(int r, int hi) { return (r & 3) + 8 * (r >> 2) + 4 * hi; }
__device__ __forceinline__ s16x4 vtr(const LAS unsigned char* p) { return __builtin_bit_cast(s16x4, __builtin_amdgcn_ds_read_tr16_b64_v4i16((LAS v4i16_t*)p)); }
constexpr int BUFB = 20480, KREG = 12288, BT_OFF = 4 * BUFB, Q_OFF = BT_OFF + 1024;

struct Ptrs { const bf16_t* Q; int ldq; const bf16_t* K; int ldk; const bf16_t* Kr; const bf16_t* V; int ldv; };

__device__ __forceinline__ float xhalf_max(float m) { auto rr = __builtin_amdgcn_permlane32_swap(__float_as_uint(m), __float_as_uint(m), false, false); return fmaxf(__uint_as_float(rr[0]), __uint_as_float(rr[1])); }
__device__ __forceinline__ float xhalf_sum(float m) { auto rr = __builtin_amdgcn_permlane32_swap(__float_as_uint(m), __float_as_uint(m), false, false); return __uint_as_float(rr[0]) + __uint_as_float(rr[1]); }

__device__ __forceinline__ void softmax_def(f32x16& p0, f32x16& p1, bool first, float cb, float& mref, f32x16& negm, float& l, f32x16& oa, f32x16& ob) {
    float a = fmaxf(fmaxf(p0[0], p0[1]), p1[0]), b = fmaxf(fmaxf(p0[2], p0[3]), p1[1]);
    a = fmaxf(fmaxf(a, p1[2]), p1[3]);
#pragma unroll
    for (int r = 4; r < 16; r += 4) { a = fmaxf(fmaxf(a, p0[r]), p0[r + 1]); b = fmaxf(fmaxf(b, p0[r + 2]), p0[r + 3]); a = fmaxf(fmaxf(a, p1[r]), p1[r + 1]); b = fmaxf(fmaxf(b, p1[r + 2]), p1[r + 3]); }
    const float rm = xhalf_max(fmaxf(a, b));
    if (first || __any(rm > 16.f)) {
        const float dl = first ? rm : fmaxf(rm, 0.f);
        mref += dl;
#pragma unroll
        for (int r = 0; r < 16; ++r) { p0[r] -= dl; p1[r] -= dl; }
        const float nm = cb - mref;
#pragma unroll
        for (int r = 0; r < 16; ++r) negm[r] = nm;
        const float f = first ? 0.f : __builtin_amdgcn_exp2f(-dl);
        l *= f;
#pragma unroll
        for (int r = 0; r < 16; ++r) { oa[r] *= f; ob[r] *= f; }
    }
    float s0 = 0.f, s1 = 0.f, s2 = 0.f, s3 = 0.f;
#pragma unroll
    for (int r = 0; r < 16; ++r) { p0[r] = __builtin_amdgcn_exp2f(p0[r]); p1[r] = __builtin_amdgcn_exp2f(p1[r]); }
#pragma unroll
    for (int r = 0; r < 16; r += 2) { s0 += p0[r]; s1 += p0[r + 1]; s2 += p1[r]; s3 += p1[r + 1]; }
    l += (s0 + s1) + (s2 + s3);
}
__device__ __forceinline__ void pack_p(const f32x16& p0, const f32x16& p1, bf16x8 (&pa)[4]) {
    u32x4 w;
    w.x = cvtpk(p0[0], p0[1]); w.y = cvtpk(p0[2], p0[3]); w.z = cvtpk(p0[4], p0[5]); w.w = cvtpk(p0[6], p0[7]); pa[0] = __builtin_bit_cast(bf16x8, w);
    w.x = cvtpk(p0[8], p0[9]); w.y = cvtpk(p0[10], p0[11]); w.z = cvtpk(p0[12], p0[13]); w.w = cvtpk(p0[14], p0[15]); pa[1] = __builtin_bit_cast(bf16x8, w);
    w.x = cvtpk(p1[0], p1[1]); w.y = cvtpk(p1[2], p1[3]); w.z = cvtpk(p1[4], p1[5]); w.w = cvtpk(p1[6], p1[7]); pa[2] = __builtin_bit_cast(bf16x8, w);
    w.x = cvtpk(p1[8], p1[9]); w.y = cvtpk(p1[10], p1[11]); w.z = cvtpk(p1[12], p1[13]); w.w = cvtpk(p1[14], p1[15]); pa[3] = __builtin_bit_cast(bf16x8, w);
}

template <int MODE>
__device__ __forceinline__ void attn_unit(LAS unsigned char* lds, const Ptrs& P, int nq, int nt_block, int qpos0, bool sample, int h,
                                          const float* relb  , const float* lamp, const float* subg, bf16_t* Obase  , int wv) {
    const int tid = otid(wv);
    const int lane = tid & 63, r32 = lane & 31, hi = lane >> 5;
    const int wid = __builtin_amdgcn_readfirstlane(tid >> 6);
    const bool wact = (wid * 32 < nq);
    int ntw = sample ? nt_block : (((qpos0 + wid * 32) >> 6) + 1);
    if (!wact) ntw = 0;
    constexpr int NQF = (MODE == 0) ? 4 : 6;
    bf16x8 qf[NQF];
    {
        const int qr = wact ? (wid * 32 + r32) : 0;
        const bf16_t* qp = P.Q + (size_t)qr * P.ldq + hi * 8;
#pragma unroll
        for (int i = 0; i < NQF; ++i) qf[i] = *(const bf16x8*)(qp + i * 16);
    }
    LAS float* bt = (LAS float*)(lds + BT_OFF);
    float cbias = 0.f;
    if (MODE == 0) {
        if (tid < 256) {
            const int rel = tid - 192;
            const int n = rel < 0 ? -rel : rel;
            int bk = rel > 0 ? 16 : 0;
            if (n < 8) bk += n; else { int lg = 2 + (31 - __clz(n * n)); bk += (lg > 15 ? 15 : lg); }
            bt[tid] = relb[bk * 6 + h] * LOG2E;
        }
        cbias = relb[15 * 6 + h] * LOG2E;
    }
    const bf16_t* kg = P.K + (size_t)lane * P.ldk + wid * 8;
    const bf16_t* krg = (MODE == 1) ? (P.Kr + (size_t)lane * 32 + (wid & 3) * 8) : nullptr;
    const bf16_t* vg = P.V + (size_t)(16 * (wid & 3) + (lane >> 2)) * P.ldv + (wid >> 2) * 32 + (lane & 3) * 8;
    const int kdst = wid * 1024 + lane * 16, krdst = (8 + (wid & 3)) * 1024 + lane * 16, vdst = KREG + wid * 1024 + lane * 16;
    const int nst = (nt_block + 1) >> 1;
    u32x4 kreg[2], vreg[2], krreg[2];
#pragma unroll
    for (int j = 0; j < 2; ++j) {
        const int tt = (j < nt_block) ? j : (nt_block - 1);
        kreg[j] = *(const u32x4*)(kg + (size_t)tt * 64 * P.ldk); vreg[j] = *(const u32x4*)(vg + (size_t)tt * 64 * P.ldv);
        krreg[j] = (u32x4){0, 0, 0, 0};
        if (MODE == 1) { if (wid < 4) krreg[j] = *(const u32x4*)(krg + (size_t)tt * 64 * 32); }
    }
    float mr1 = 0.f, l1 = 0.f, mr2 = 0.f, l2 = 0.f;
    f32x16 o1a = {}, o1b = {}, o2a = {}, o2b = {};
    f32x16 ng1, ng2;
#pragma unroll
    for (int r = 0; r < 16; ++r) { ng1[r] = cbias; ng2[r] = cbias; }
    const int qmin = qpos0 + wid * 32, qposl = qmin + r32;
    const int vrd = ((lane >> 4) & 1) * 32 + (lane & 3) * 8 + (4 * hi + ((lane & 15) >> 2)) * 64;

    for (int st = 0; st < nst; ++st) {
        LAS unsigned char* sbuf = lds + (st & 1) * (2 * BUFB);
#pragma unroll
        for (int j = 0; j < 2; ++j) {
            *(LAS u32x4*)(sbuf + j * BUFB + kdst) = kreg[j];
            *(LAS u32x4*)(sbuf + j * BUFB + vdst) = vreg[j];
            if (MODE == 1) { if (wid < 4) *(LAS u32x4*)(sbuf + j * BUFB + krdst) = krreg[j]; }
        }
        __syncthreads();
        if (st + 1 < nst) {
#pragma unroll
            for (int j = 0; j < 2; ++j) {
                int tt = 2 * (st + 1) + j; tt = (tt < nt_block) ? tt : (nt_block - 1);
                kreg[j] = *(const u32x4*)(kg + (size_t)tt * 64 * P.ldk); vreg[j] = *(const u32x4*)(vg + (size_t)tt * 64 * P.ldv);
                if (MODE == 1) { if (wid < 4) krreg[j] = *(const u32x4*)(krg + (size_t)tt * 64 * 32); }
            }
        }
#pragma unroll 1
        for (int j = 0; j < 2; ++j) {
            const int t = 2 * st + j;
            if (t >= ntw) break;
            const LAS unsigned char* buf = sbuf + j * BUFB;
            const LAS unsigned char* kb = buf + hi * 1024 + r32 * 16;
            const LAS unsigned char* vp = buf + KREG + vrd;
            const bool first = (t == 0);
#define SB() __builtin_amdgcn_sched_barrier(0)
#define VLOADH(vf, h0) do { _Pragma("unroll") for (int ks = 2 * (h0); ks < 2 * (h0) + 2; ++ks) { \
                    const s16x4 lo0 = vtr(vp + ks * 1024), hi0 = vtr(vp + ks * 1024 + 512); \
                    const s16x4 lo1 = vtr(vp + 4096 + ks * 1024), hi1 = vtr(vp + 4096 + ks * 1024 + 512); \
                    vf[2 * ks] = (bf16x8){lo0[0], lo0[1], lo0[2], lo0[3], hi0[0], hi0[1], hi0[2], hi0[3]}; \
                    vf[2 * ks + 1] = (bf16x8){lo1[0], lo1[1], lo1[2], lo1[3], hi1[0], hi1[1], hi1[2], hi1[3]}; } } while (0)
#define VLOAD(vf) do { _Pragma("unroll") for (int ks = 0; ks < 4; ++ks) { \
                    const s16x4 lo0 = vtr(vp + ks * 1024), hi0 = vtr(vp + ks * 1024 + 512); \
                    const s16x4 lo1 = vtr(vp + 4096 + ks * 1024), hi1 = vtr(vp + 4096 + ks * 1024 + 512); \
                    vf[2 * ks] = (bf16x8){lo0[0], lo0[1], lo0[2], lo0[3], hi0[0], hi0[1], hi0[2], hi0[3]}; \
                    vf[2 * ks + 1] = (bf16x8){lo1[0], lo1[1], lo1[2], lo1[3], hi1[0], hi1[1], hi1[2], hi1[3]}; } } while (0)
            if (MODE == 1) {
                f32x16 p0, p1;
                bf16x8 kf[12];
#pragma unroll
                for (int ks = 0; ks < 6; ++ks) { kf[2 * ks] = *(const LAS bf16x8*)(kb + ks * 2048); kf[2 * ks + 1] = *(const LAS bf16x8*)(kb + ks * 2048 + 512); }
                SB();
                p0 = __builtin_amdgcn_mfma_f32_32x32x16_bf16(kf[0], qf[0], ng1, 0, 0, 0);
                p1 = __builtin_amdgcn_mfma_f32_32x32x16_bf16(kf[1], qf[0], ng1, 0, 0, 0);
#pragma unroll
                for (int ks = 1; ks < 6; ++ks) {
                    p0 = __builtin_amdgcn_mfma_f32_32x32x16_bf16(kf[2 * ks], qf[ks], p0, 0, 0, 0);
                    p1 = __builtin_amdgcn_mfma_f32_32x32x16_bf16(kf[2 * ks + 1], qf[ks], p1, 0, 0, 0);
                }
                bf16x8 vf[8]; VLOAD(vf);
                softmax_def(p0, p1, first, 0.f, mr1, ng1, l1, o1a, o1b);
                bf16x8 pa[4]; pack_p(p0, p1, pa);
#pragma unroll
                for (int ks = 0; ks < 4; ++ks) {
                    o1a = __builtin_amdgcn_mfma_f32_32x32x16_bf16(vf[2 * ks], pa[ks], o1a, 0, 0, 0);
                    o1b = __builtin_amdgcn_mfma_f32_32x32x16_bf16(vf[2 * ks + 1], pa[ks], o1b, 0, 0, 0);
                }
            } else {
                const int k0 = t * 64;
                const bool farT = (k0 + 63 - qmin <= -91);
                const int ib = k0 - qposl + 192 + 4 * hi;
                bf16x8 pa[4], pb[4];
                bf16x8 kf[4], kg2[4];
#pragma unroll
                for (int ks = 0; ks < 2; ++ks) { kf[2 * ks] = *(const LAS bf16x8*)(kb + ks * 2048); kf[2 * ks + 1] = *(const LAS bf16x8*)(kb + ks * 2048 + 512); }
                {
                    f32x16 p0, p1;
                    if (farT) {
                        p0 = __builtin_amdgcn_mfma_f32_32x32x16_bf16(kf[0], qf[0], ng1, 0, 0, 0);
                        p1 = __builtin_amdgcn_mfma_f32_32x32x16_bf16(kf[1], qf[0], ng1, 0, 0, 0);
                    } else {
                        const float nb = ng1[0] - cbias;
#pragma unroll
                        for (int r = 0; r < 16; ++r) { const int idx = ib + (r & 3) + 8 * (r >> 2); p0[r] = bt[idx] + nb; p1[r] = bt[idx + 32] + nb; }
                        p0 = __builtin_amdgcn_mfma_f32_32x32x16_bf16(kf[0], qf[0], p0, 0, 0, 0);
                        p1 = __builtin_amdgcn_mfma_f32_32x32x16_bf16(kf[1], qf[0], p1, 0, 0, 0);
                    }
                    p0 = __builtin_amdgcn_mfma_f32_32x32x16_bf16(kf[2], qf[1], p0, 0, 0, 0);
                    p1 = __builtin_amdgcn_mfma_f32_32x32x16_bf16(kf[3], qf[1], p1, 0, 0, 0);
#pragma unroll
                    for (int ks = 0; ks < 2; ++ks) { kg2[2 * ks] = *(const LAS bf16x8*)(kb + 4096 + ks * 2048); kg2[2 * ks + 1] = *(const LAS bf16x8*)(kb + 4096 + ks * 2048 + 512); }
                    softmax_def(p0, p1, first, cbias, mr1, ng1, l1, o1a, o1b);
                    pack_p(p0, p1, pa);
                }
                bf16x8 vf[8];
                {
                    f32x16 s0, s1;
                    if (farT) {
                        s0 = __builtin_amdgcn_mfma_f32_32x32x16_bf16(kg2[0], qf[2], ng2, 0, 0, 0);
                        s1 = __builtin_amdgcn_mfma_f32_32x32x16_bf16(kg2[1], qf[2], ng2, 0, 0, 0);
                    } else {
                        const float nb = ng2[0] - cbias;
#pragma unroll
                        for (int r = 0; r < 16; ++r) { const int idx = ib + (r & 3) + 8 * (r >> 2); s0[r] = bt[idx] + nb; s1[r] = bt[idx + 32] + nb; }
                        s0 = __builtin_amdgcn_mfma_f32_32x32x16_bf16(kg2[0], qf[2], s0, 0, 0, 0);
                        s1 = __builtin_amdgcn_mfma_f32_32x32x16_bf16(kg2[1], qf[2], s1, 0, 0, 0);
                    }
                    s0 = __builtin_amdgcn_mfma_f32_32x32x16_bf16(kg2[2], qf[3], s0, 0, 0, 0);
                    s1 = __builtin_amdgcn_mfma_f32_32x32x16_bf16(kg2[3], qf[3], s1, 0, 0, 0);
                    softmax_def(s0, s1, first, cbias, mr2, ng2, l2, o2a, o2b);
                    pack_p(s0, s1, pb);
                }
                VLOADH(vf, 0); VLOADH(vf, 1);
#pragma unroll
                for (int ks = 0; ks < 4; ++ks) {
                    o1a = __builtin_amdgcn_mfma_f32_32x32x16_bf16(vf[2 * ks], pa[ks], o1a, 0, 0, 0);
                    o1b = __builtin_amdgcn_mfma_f32_32x32x16_bf16(vf[2 * ks + 1], pa[ks], o1b, 0, 0, 0);
                    o2a = __builtin_amdgcn_mfma_f32_32x32x16_bf16(vf[2 * ks], pb[ks], o2a, 0, 0, 0);
                    o2b = __builtin_amdgcn_mfma_f32_32x32x16_bf16(vf[2 * ks + 1], pb[ks], o2b, 0, 0, 0);
                }
            }
#undef SB
#undef VLOAD
#undef VLOADH
        }
    }
    if (wact) {
        const float lt1 = xhalf_sum(l1);
        const float i1 = 1.f / lt1;
        bf16_t* orow = Obase + (size_t)(wid * 32 + r32) * 1024;
        if (MODE == 1) {
#pragma unroll
            for (int g = 0; g < 4; ++g) {
                u32x2 w; w.x = cvtpk(o1a[4 * g] * i1, o1a[4 * g + 1] * i1); w.y = cvtpk(o1a[4 * g + 2] * i1, o1a[4 * g + 3] * i1);
                *(u32x2*)(orow + 8 * g + 4 * hi) = w;
                w.x = cvtpk(o1b[4 * g] * i1, o1b[4 * g + 1] * i1); w.y = cvtpk(o1b[4 * g + 2] * i1, o1b[4 * g + 3] * i1);
                *(u32x2*)(orow + 32 + 8 * g + 4 * hi) = w;
            }
        } else {
            const float lt2 = xhalf_sum(l2);
            const float lam = lamp[0], lam_init = lamp[1];
            const float i2 = lam / lt2;
            float va[16], vb[16], ss = 0.f;
#pragma unroll
            for (int r = 0; r < 16; ++r) { va[r] = o1a[r] * i1 - o2a[r] * i2; vb[r] = o1b[r] * i1 - o2b[r] * i2; ss += va[r] * va[r] + vb[r] * vb[r]; }
            ss = xhalf_sum(ss);
            const float rs = rsqrtf(ss * (1.f / 64.f) + EPS) * (1.f - lam_init);
#pragma unroll
            for (int g = 0; g < 4; ++g) {
                const int d = 8 * g + 4 * hi;
                const f32x4 ga = *(const f32x4*)(subg + d), gb = *(const f32x4*)(subg + 32 + d);
                u32x2 w; w.x = cvtpk(va[4 * g] * rs * ga[0], va[4 * g + 1] * rs * ga[1]); w.y = cvtpk(va[4 * g + 2] * rs * ga[2], va[4 * g + 3] * rs * ga[3]);
                *(u32x2*)(orow + d) = w;
                w.x = cvtpk(vb[4 * g] * rs * gb[0], vb[4 * g + 1] * rs * gb[1]); w.y = cvtpk(vb[4 * g + 2] * rs * gb[2], vb[4 * g + 3] * rs * gb[3]);
                *(u32x2*)(orow + 32 + d) = w;
            }
        }
    }
    __syncthreads();
}
}

__device__ __forceinline__ void gemv24_item(LAS float* cs, LAS float* red, int tid, const float* W, int ldw, int srcn0, int nvalid, const float* bias, float scale, float* out, int ldo, int n0) {
    const int ks = tid >> 6, col = tid & 63;
    const float* w = W + srcn0 + col;
    float acc[24];
#pragma unroll
    for (int r = 0; r < 24; ++r) acc[r] = 0.f;
    if (col < nvalid) {
#pragma unroll 1
        for (int k = ks * 128; k < ks * 128 + 128; k += 8) {
            float wq[8];
#pragma unroll
            for (int j = 0; j < 8; ++j) wq[j] = w[(size_t)(k + j) * ldw];
#pragma unroll
            for (int j4 = 0; j4 < 2; ++j4)
#pragma unroll
                for (int r = 0; r < 24; ++r) { const f32x4 c4 = *(const LAS f32x4*)(cs + r * 1024 + k + 4 * j4); acc[r] += c4[0] * wq[4 * j4] + c4[1] * wq[4 * j4 + 1] + c4[2] * wq[4 * j4 + 2] + c4[3] * wq[4 * j4 + 3]; }
        }
    }
#pragma unroll
    for (int r = 0; r < 24; ++r) red[(ks * 24 + r) * 64 + col] = acc[r];
    __syncthreads();
    for (int i = tid; i < 24 * 64; i += NTHREADS) {
        const int r = i >> 6, c = i & 63; float sm = bias ? bias[n0 + c] : 0.f;
#pragma unroll
        for (int k8 = 0; k8 < 8; ++k8) sm += red[(k8 * 24 + r) * 64 + c];
        out[(size_t)r * ldo + n0 + c] = sm * scale;
    }
    __syncthreads();
}

__device__ __forceinline__ void shw_phase(const Args& a, LAS unsigned char* lds, int wv) {
    const int tid = otid(wv), G = gridDim.x, bx = blockIdx.x;
    LAS float* cs = (LAS float*)lds; LAS float* red = (LAS float*)(lds + 98304);
    for (int it = bx; it < 208; it += G) {
        int l, off, n0; const float* W; int ldw, srcn0, nvalid = 64; float* out; int ldo; float scale = 1.f;
        if (it < 176) {
            l = it / 88; n0 = (it % 88) * 64; off = 3072; W = a.in[28] + (size_t)l * 1024 * 5632; ldw = 5632;
            const int tile = n0 >> 8, within = n0 & 255; srcn0 = (within < 128) ? tile * 128 + within : FFN + tile * 128 + (within - 128);
            out = (float*)(a.ws + WS_SHW2) + (size_t)l * 24 * 5632; ldo = 5632;
        } else {
            l = 1; n0 = (it - 176) * 64; off = 0; W = a.in[13] + (size_t)l * 1024 * INC; ldw = INC; srcn0 = n0;
            nvalid = INC - n0; nvalid = nvalid < 0 ? 0 : (nvalid > 64 ? 64 : nvalid);
            out = (float*)(a.ws + WS_SHW1) + (size_t)l * 24 * INPAD; ldo = INPAD;
            if (n0 < 384) scale = 0.17677669529663687f * LOG2E;
        }
        const float* mod = (const float*)(a.ws + WS_MOD) + (size_t)l * 24 * 6144 + off;
        for (int i = tid; i < 24 * 1024; i += NTHREADS) cs[i] = mod[(size_t)(i >> 10) * 6144 + (i & 1023)];
        __syncthreads();
        gemv24_item(cs, red, tid, W, ldw, srcn0, nvalid, nullptr, scale, out, ldo, n0);
    }
}

__device__ __forceinline__ void prologue_phase(const Args& a, LAS unsigned char* lds, int wv) {
    unsigned char* ws = a.ws;
    const int tid = otid(wv), G = gridDim.x, bx = blockIdx.x;
    if (bx == 0) { unsigned* bw = (unsigned*)(ws + WS_BAR); for (int i = tid; i < XCD_BAR_WORDS; i += NTHREADS) bw[i] = 0u; }
    if (bx == 0 && tid < 64) {
        unsigned* ctl = (unsigned*)(ws + WS_CTL);
        if (tid < 32) ctl[tid] = 0u;
        if (tid < 16) ctl[48 + tid] = 0u;
        if (tid >= 32 && tid < 34) {
            const int l = tid - 32; float s1 = 0.f, s2 = 0.f;
            for (int i = 0; i < 32; ++i) { s1 += a.in[14][l * 32 + i] * a.in[15][l * 32 + i]; s2 += a.in[16][l * 32 + i] * a.in[17][l * 32 + i]; }
            const float li = 0.8f - 0.6f * expf(-0.3f * (float)l);
            float* lamv = (float*)(ws + WS_CTL + 256);
            lamv[l * 2] = expf(s1) - expf(s2) + li; lamv[l * 2 + 1] = li;
        }
    }
    {
        float* rope = (float*)(ws + WS_ROPE);
        for (int idx = bx * NTHREADS + tid; idx < TKS * 16; idx += G * NTHREADS) {
            const int pos = idx >> 4, i = idx & 15;
            const float angf = (float)pos * a.inv_freq[i];
            const double ang = (double)angf;
            const double nq = rint(ang * 0.63661977236758134308);
            const double rr = fma(-nq, 1.57079632679489661923, ang) - nq * 6.123233995736766e-17;
            const double r2 = rr * rr;
            const double sn = rr * (1.0 + r2 * (-1.0 / 6 + r2 * (1.0 / 120 + r2 * (-1.0 / 5040 + r2 * (1.0 / 362880 + r2 * (-1.0 / 39916800))))));
            const double cs = 1.0 + r2 * (-0.5 + r2 * (1.0 / 24 + r2 * (-1.0 / 720 + r2 * (1.0 / 40320 + r2 * (-1.0 / 3628800 + r2 * (1.0 / 479001600))))));
            const int q = (int)((long long)nq & 3);
            double c, s;
            if (q == 0) { c = cs; s = sn; } else if (q == 1) { c = -sn; s = cs; } else if (q == 2) { c = -cs; s = -sn; } else { c = sn; s = -cs; }
            rope[idx * 2] = (float)c; rope[idx * 2 + 1] = (float)s;
        }
    }
    {
        float* rsz = (float*)(ws + WS_RS);
        for (int i = bx * NTHREADS + tid; i < 3 * MT; i += G * NTHREADS) rsz[i] = 0.f;
    }
    {
        LAS float* cs = (LAS float*)lds;
        LAS float* red = (LAS float*)(lds + 98304);
        bool cs_ready = false;
        for (int it = bx; it < 192; it += G) {
            if (!cs_ready) {
                for (int i = tid; i < 24 * 1024; i += NTHREADS) { const int r = i >> 10, k = i & 1023; const float c = (r < 16) ? a.in[2][r * 1024 + k] : a.in[3][(r - 16) * 1024 + k]; cs[i] = c / (1.f + __expf(-c)); }
                cs_ready = true;
                __syncthreads();
            }
            const int l = it / 96, n0 = (it % 96) * 64;
            gemv24_item(cs, red, tid, a.in[10] + (size_t)l * 1024 * 6144, 6144, n0, 64, a.in[11] + l * 6144, 1.f, (float*)(ws + WS_MOD) + (size_t)l * 24 * 6144, 6144, n0);
        }
        __syncthreads();
    }
    {
        LAS float* tl = (LAS float*)lds;
        constexpr int NT_IN = 32 * 16, NT_Q = 12 * 4, NT_KV = 12 * 2, NT_O = 16 * 16, NT_UP = 88 * 16, NT_DN = 16 * 44;
        constexpr int NT_L = NT_IN + NT_Q + NT_KV + NT_O + NT_UP + NT_DN;
        const int n_main = (G == 256) ? 20 * 256 : 2 * NT_L;
        const int n_iter = (G == 256) ? ((bx < 192) ? 20 : 20 + (2 * NT_L - n_main + 63) / 64) : (2 * NT_L + G - 1) / G;
        for (int k = 0; k < n_iter; ++k) {
            int it;
            if (G == 256) it = (k < 20) ? bx + k * 256 : n_main + (bx - 192) + (k - 20) * 64; else it = bx + k * G;
            if (it >= 2 * NT_L) break;
            const int l = it / NT_L; int r = it % NT_L;
            const float* W; bf16_t* WT; int K, N, nkt; int mode = 0; float scale = 1.f; int scale_cols = 0;
            if (r < NT_IN) { W = a.in[13] + (size_t)l * 1024 * INC; WT = (bf16_t*)(ws + WS_WIN) + (size_t)l * INPAD * 1024; K = 1024; N = INC; scale = 0.17677669529663687f * LOG2E; scale_cols = 384; }
            else if ((r -= NT_IN) < NT_Q) { W = a.in[23] + (size_t)l * 256 * 576; WT = (bf16_t*)(ws + WS_WQUP) + (size_t)l * 768 * 256; K = 256; N = 576; scale = 0.10206207261596575f * LOG2E; scale_cols = 576; }
            else if ((r -= NT_Q) < NT_KV) { W = a.in[25] + (size_t)l * 128 * 768; WT = (bf16_t*)(ws + WS_WKV) + (size_t)l * 768 * 128; K = 128; N = 768; }
            else if ((r -= NT_KV) < NT_O) { W = a.in[26] + (size_t)l * 1024 * 1024; WT = (bf16_t*)(ws + WS_WOUT) + (size_t)l * 1024 * 1024; K = 1024; N = 1024; }
            else if ((r -= NT_O) < NT_UP) { W = a.in[28] + (size_t)l * 1024 * 5632; WT = (bf16_t*)(ws + WS_WUP) + (size_t)l * 5632 * 1024; K = 1024; N = 5632; mode = 1; }
            else { r -= NT_UP; W = a.in[31] + (size_t)l * FFN * 1024; WT = (bf16_t*)(ws + WS_WDN) + (size_t)l * 1024 * FFN; K = FFN; N = 1024; }
            nkt = K / 64;
            const int n0 = (r / nkt) * 64, k0 = (r % nkt) * 64;
            int srcn0 = n0;
            if (mode == 1) { const int tile = n0 >> 8, within = n0 & 255; srcn0 = (within < 128) ? tile * 128 + within : FFN + tile * 128 + (within - 128); }
            int nvalid = N - n0; nvalid = nvalid < 0 ? 0 : (nvalid > 64 ? 64 : nvalid);
            const float sc = (n0 < scale_cols) ? scale : 1.f;
#pragma unroll
            for (int i = 0; i < 8; ++i) {
                const int k = i * 8 + (tid >> 6), n = tid & 63;
                tl[k * 65 + n] = (n < nvalid) ? W[(size_t)(k0 + k) * N + srcn0 + n] * sc : 0.f;
            }
            __syncthreads();
            {
                const int n = tid >> 3, kc = (tid & 7) * 8;
                u32x4 w;
                w.x = cvtpk(tl[(kc + 0) * 65 + n], tl[(kc + 1) * 65 + n]); w.y = cvtpk(tl[(kc + 2) * 65 + n], tl[(kc + 3) * 65 + n]);
                w.z = cvtpk(tl[(kc + 4) * 65 + n], tl[(kc + 5) * 65 + n]); w.w = cvtpk(tl[(kc + 6) * 65 + n], tl[(kc + 7) * 65 + n]);
                *(u32x4*)(WT + (size_t)(n0 + n) * K + k0 + kc) = w;
            }
            __syncthreads();
        }
    }
}

__device__ __forceinline__ void norm_phase(const Args& a, int l, int which, bool from_input, int wv) {
    const int tid_ = otid(wv); const int lane = tid_ & 63, wid = tid_ >> 6;
    const float* g = a.in[which ? 27 : 12] + l * 1024;
    const float* mod = (const float*)(a.ws + WS_MOD) + (size_t)l * 24 * 6144;
    const int sh_off = which ? 3072 : 0, sc_off = which ? 4096 : 1024;
    bf16_t* H = (bf16_t*)(a.ws + WS_H);
    const float* xbuf = a.out;
    const int nw = gridDim.x * 8;
    for (int rb = blockIdx.x * 8 + wid; rb < MT; rb += nw * 4) {
        f32x4 v[4][4];
#pragma unroll
        for (int j = 0; j < 4; ++j) {
            const int row = rb + j * nw;
            if (row < MT) {
                const float* x = from_input ? ((row < MP) ? a.in[0] + (size_t)row * DM : a.in[1] + (size_t)(row - MP) * DM) : xbuf + (size_t)row * DM;
#pragma unroll
                for (int i = 0; i < 4; ++i) v[j][i] = from_input ? __builtin_nontemporal_load((const f32x4*)(x + i * 256 + lane * 4)) : *(const f32x4*)(x + i * 256 + lane * 4);
            }
        }
#pragma unroll
        for (int j = 0; j < 4; ++j) {
            const int row = rb + j * nw;
            if (row < MT) {
                const int b = batch_of(row);
                float ss = 0.f;
#pragma unroll
                for (int i = 0; i < 4; ++i) ss += v[j][i][0] * v[j][i][0] + v[j][i][1] * v[j][i][1] + v[j][i][2] * v[j][i][2] + v[j][i][3] * v[j][i][3];
                ss = wave_sum(ss);
                const float rstd = rsqrtf(ss * (1.f / 1024.f) + EPS);
                const float* mb = mod + (size_t)b * 6144;
#pragma unroll
                for (int i = 0; i < 4; ++i) {
                    const int c = i * 256 + lane * 4;
                    const f32x4 g4 = *(const f32x4*)(g + c), sc4 = *(const f32x4*)(mb + sc_off + c), sh4 = *(const f32x4*)(mb + sh_off + c);
                    f32x4 y;
#pragma unroll
                    for (int e = 0; e < 4; ++e) y[e] = v[j][i][e] * rstd * g4[e] * (1.f + sc4[e]) + sh4[e];
                    u32x2 w; w.x = cvtpk(y[0], y[1]); w.y = cvtpk(y[2], y[3]);
                    *(u32x2*)(H + (size_t)row * DM + c) = w;
                }
            }
        }
    }
}

__device__ __forceinline__ void post_phase(const Args& a, int l, int wv, int row_lo, int row_hi, int bidx, int nblk, bool do_cache) {
    unsigned char* ws = a.ws;
    const int tid_ = otid(wv); const int lane = tid_ & 63, wid = tid_ >> 6;
    const bf16_t* U = (const bf16_t*)(ws + WS_U);
    bf16_t* CQN = (bf16_t*)(ws + WS_CQN); bf16_t* LAT = (bf16_t*)(ws + WS_LAT); bf16_t* KR = (bf16_t*)(ws + WS_KR);
    bf16_t* KS = (bf16_t*)(ws + WS_KS); bf16_t* VS = (bf16_t*)(ws + WS_VS);
    const float* rope = (const float*)(ws + WS_ROPE);
    const float* gq = a.in[22] + l * 256; const float* gkv = a.in[24] + l * 128;
    float* latp = a.out + O_LATP + (size_t)l * MP * 128; float* lats = a.out + O_LATS + (size_t)l * MS * 128;
    float* krp = a.out + O_KRP + (size_t)l * MP * 32; float* krs = a.out + O_KRS + (size_t)l * MS * 32;
    const int nw = nblk * 8;
    const int MT = row_hi;
    for (int rb = row_lo + bidx * 8 + wid; rb < MT; rb += nw * 4) {
        u32x2 cqv[4]; unsigned ckvv[4]; unsigned short ckrv[4];
#pragma unroll
        for (int j = 0; j < 4; ++j) {
            const int row = rb + j * nw;
            cqv[j] = (u32x2){0u, 0u}; ckvv[j] = 0u; ckrv[j] = 0;
            if (row < MT) {
                const bf16_t* ur = U + (size_t)row * INC;
                cqv[j] = *(const u32x2*)(ur + 1408 + lane * 4); ckvv[j] = *(const unsigned*)(ur + 1664 + lane * 2); ckrv[j] = ur[1792 + (lane & 31)];
            }
        }
#pragma unroll
        for (int j = 0; j < 4; ++j) {
            const int row = rb + j * nw;
            if (row >= MT) continue;
            const bf16_t* ur = U + (size_t)row * INC;
            const size_t kvr = kvrow_of(row);
            {
                const u32x2 w = cqv[j];
                float x[4] = {bf2f((unsigned short)(w.x & 0xffff)), bf2f((unsigned short)(w.x >> 16)), bf2f((unsigned short)(w.y & 0xffff)), bf2f((unsigned short)(w.y >> 16))};
                float ss = wave_sum(x[0] * x[0] + x[1] * x[1] + x[2] * x[2] + x[3] * x[3]);
                const float rstd = rsqrtf(ss * (1.f / 256.f) + EPS);
                const f32x4 g4 = *(const f32x4*)(gq + lane * 4);
                u32x2 o; o.x = cvtpk(x[0] * rstd * g4[0], x[1] * rstd * g4[1]); o.y = cvtpk(x[2] * rstd * g4[2], x[3] * rstd * g4[3]);
                *(u32x2*)(CQN + (size_t)row * 256 + lane * 4) = o;
            }
            {
                const unsigned w = ckvv[j];
                const float x0 = bf2f((unsigned short)(w & 0xffff)), x1 = bf2f((unsigned short)(w >> 16));
                float ss = wave_sum(x0 * x0 + x1 * x1);
                const float rstd = rsqrtf(ss * (1.f / 128.f) + EPS);
                const float y0 = x0 * rstd * gkv[lane * 2], y1 = x1 * rstd * gkv[lane * 2 + 1];
                float* lo = (row < MP) ? latp + (size_t)row * 128 : lats + (size_t)(row - MP) * 128;
                __builtin_nontemporal_store((f32x2_t){y0, y1}, (f32x2_t*)(lo + lane * 2));
                *(unsigned*)(LAT + kvr * 128 + lane * 2) = cvtpk(y0, y1);
            }
            {
                const float x = bf2f(ckrv[j]);
                const float pv = __shfl_xor(x, 16);
                const int pos = pos_of(row);
                const int i = lane & 15;
                const float cs = rope[((size_t)pos * 16 + i) * 2], sn = rope[((size_t)pos * 16 + i) * 2 + 1];
                const float y = ((lane & 16) == 0) ? (x * cs - pv * sn) : (x * cs + pv * sn);
                const float yn = __shfl_down(y, 1);
                if (lane < 32) {
                    float* ko = (row < MP) ? krp + (size_t)row * 32 : krs + (size_t)(row - MP) * 32;
                    ko[lane] = y;
                    if ((lane & 1) == 0) *(unsigned*)(KR + kvr * 32 + lane) = cvtpk(y, yn);
                }
            }
            if (row >= MP) {
                const int rs = row - MP; const size_t dst = ((size_t)(rs >> 6) * TKS + PAST + (rs & 63)) * 384;
                if (lane < 48) { *(u32x4*)(KS + dst + lane * 8) = *(const u32x4*)(ur + 384 + lane * 8); *(u32x4*)(VS + dst + lane * 8) = *(const u32x4*)(ur + 768 + lane * 8); }
            }
        }
    }
    if (do_cache) {
        const size_t gtid = (size_t)bidx * NTHREADS + tid_, gsz = (size_t)nblk * NTHREADS;
        const float* ck = a.in[4] + (size_t)l * NBS * PAST * 384; const float* cv = a.in[5] + (size_t)l * NBS * PAST * 384;
        const size_t n1 = (size_t)NBS * PAST * 96;
        for (size_t i0 = gtid; i0 < n1; i0 += gsz * 4) {
            f32x4 k4[4], v4[4];
#pragma unroll
            for (int j = 0; j < 4; ++j) { const size_t i = i0 + j * gsz; if (i < n1) { const size_t rowi = i / 96; const int c = (int)(i % 96) * 4; k4[j] = __builtin_nontemporal_load((const f32x4*)(ck + rowi * 384 + c)); v4[j] = __builtin_nontemporal_load((const f32x4*)(cv + rowi * 384 + c)); } }
#pragma unroll
            for (int j = 0; j < 4; ++j) { const size_t i = i0 + j * gsz; if (i < n1) { const size_t rowi = i / 96; const int c = (int)(i % 96) * 4; const size_t b = rowi >> 12, t = rowi & 4095;
                const size_t d = (b * TKS + t) * 384 + c;
                u32x2 w; w.x = cvtpk(k4[j][0], k4[j][1]); w.y = cvtpk(k4[j][2], k4[j][3]); *(u32x2*)(KS + d) = w;
                w.x = cvtpk(v4[j][0], v4[j][1]); w.y = cvtpk(v4[j][2], v4[j][3]); *(u32x2*)(VS + d) = w; } }
        }
        const float* cl = a.in[6] + (size_t)l * NBS * PAST * 128;
        const size_t n2 = (size_t)NBS * PAST * 32;
        for (size_t i0 = gtid; i0 < n2; i0 += gsz * 4) {
            f32x4 x4[4];
#pragma unroll
            for (int j = 0; j < 4; ++j) { const size_t i = i0 + j * gsz; if (i < n2) x4[j] = __builtin_nontemporal_load((const f32x4*)(cl + i * 4)); }
#pragma unroll
            for (int j = 0; j < 4; ++j) { const size_t i = i0 + j * gsz; if (i < n2) { const size_t rowi = i / 32; const int c = (int)(i % 32) * 4; const size_t b = rowi >> 12, t = rowi & 4095;
                u32x2 w; w.x = cvtpk(x4[j][0], x4[j][1]); w.y = cvtpk(x4[j][2], x4[j][3]);
                *(u32x2*)(LAT + ((size_t)MP + b * TKS + t) * 128 + c) = w; } }
        }
        const float* cr = a.in[7] + (size_t)l * NBS * PAST * 32;
        const size_t n3 = (size_t)NBS * PAST * 8;
        for (size_t i = gtid; i < n3; i += gsz) {
            const size_t rowi = i / 8; const int c = (int)(i % 8) * 4; const size_t b = rowi >> 12, t = rowi & 4095;
            const f32x4 x4 = *(const f32x4*)(cr + rowi * 32 + c);
            u32x2 w; w.x = cvtpk(x4[0], x4[1]); w.y = cvtpk(x4[2], x4[3]);
            *(u32x2*)(KR + ((size_t)MP + b * TKS + t) * 32 + c) = w;
        }
    }
}

__device__ __forceinline__ void pool_unit(const Args& a, int l, int gi, LAS unsigned char* lds, int wv) {
    const int tid = otid(wv);
    LAS bf16_t* ext = (LAS bf16_t*)lds;
    LAS bf16_t* mb = (LAS bf16_t*)(lds + 40960);
    LAS bf16_t* wt = (LAS bf16_t*)(lds + 77824);
    const bf16_t* U = (const bf16_t*)(a.ws + WS_U);
    const int row0 = gi * 64;
    const bool smp = row0 >= MP;
    const int t0 = smp ? 0 : (row0 & 4095);
    u32x4 c[5];
#pragma unroll
    for (int k = 0; k < 5; ++k) {
        const int q = tid + k * NTHREADS; const int e = q >> 5, ch = q & 31;
        c[k] = (u32x4){0u, 0u, 0u, 0u};
        if (q < 79 * 32 && (e >= 15 || (!smp && t0 != 0))) c[k] = *(const u32x4*)(U + (size_t)(row0 + e - 15) * INC + 1152 + ch * 8);
    }
    f32x4 wq[8];
#pragma unroll
    for (int k = 0; k < 8; ++k) wq[k] = *(const f32x4*)(a.in[20] + (size_t)l * 4 * 4096 + (size_t)(tid + k * NTHREADS) * 4);
    f32x4 hs[2] = {{0.f, 0.f, 0.f, 0.f}, {0.f, 0.f, 0.f, 0.f}};
    if (smp) {
#pragma unroll
        for (int k = 0; k < 2; ++k) { const int idx = tid + k * NTHREADS; if (idx < 960) hs[k] = *(const f32x4*)(a.in[8] + (((size_t)l * NBS + ((row0 - MP) >> 6)) * 15) * 256 + (size_t)idx * 4); }
    }
#pragma unroll
    for (int k = 0; k < 5; ++k) {
        const int q = tid + k * NTHREADS; const int e = q >> 5, ch = q & 31;
        if (q < 79 * 32 && !(smp && e < 15)) *(LAS u32x4*)(ext + e * 256 + ch * 8) = c[k];
    }
    if (smp) {
#pragma unroll
        for (int k = 0; k < 2; ++k) { const int idx = tid + k * NTHREADS; if (idx < 960) { u32x2 o; o.x = cvtpk(hs[k][0], hs[k][1]); o.y = cvtpk(hs[k][2], hs[k][3]); *(LAS u32x2*)(ext + idx * 4) = o; } }
    }
#pragma unroll
    for (int k = 0; k < 8; ++k) {
        const int idx = tid + k * NTHREADS; const int g = idx >> 10, within = idx & 1023, c0 = within >> 4, d4 = (within & 15) * 4;
#pragma unroll
        for (int i2 = 0; i2 < 4; ++i2) wt[(g * 64 + d4 + i2) * 72 + c0] = (bf16_t)(cvtpk(wq[k][i2], 0.f) & 0xffff);
    }
    __syncthreads();
    {
        const int cc = tid & 63, tb = (tid >> 6) * 8;
#pragma unroll
        for (int g = 0; g < 4; ++g) {
            const int w = 2 << g, ch = g * 64 + cc;
            float S = 0.f;
            for (int j2 = 1; j2 < w; ++j2) S += bf2f(ext[(15 + tb - j2) * 256 + ch]);
#pragma unroll
            for (int jj = 0; jj < 8; ++jj) {
                const int t = tb + jj;
                const float cur = bf2f(ext[(15 + t) * 256 + ch]);
                S += cur;
                int cnt = w; if (!smp) { const int p = t0 + t + 1; cnt = p < w ? p : w; }
                mb[t * 288 + g * 72 + cc] = (bf16_t)(cvtpk(S / (float)cnt - cur, 0.f) & 0xffff);
                S -= bf2f(ext[(15 + t - w + 1) * 256 + ch]);
            }
        }
    }
    __syncthreads();
    {
        const int lane = tid & 63, wvi = tid >> 6, fr = lane & 15, fq = lane >> 4;
        bf16_t* MIX = (bf16_t*)(a.ws + WS_MIX);
#pragma unroll
        for (int i2 = 0; i2 < 8; ++i2) {
            const int T = wvi * 8 + i2; const int g = T >> 4, tm = (T >> 2) & 3, tn = T & 3;
            f32x4 acc = {0.f, 0.f, 0.f, 0.f};
#pragma unroll
            for (int ks = 0; ks < 2; ++ks) {
                const bf16x8 af = *(const LAS bf16x8*)(mb + (tm * 16 + fr) * 288 + g * 72 + ks * 32 + fq * 8);
                const bf16x8 bfr = *(const LAS bf16x8*)(wt + (g * 64 + tn * 16 + fr) * 72 + ks * 32 + fq * 8);
                acc = __builtin_amdgcn_mfma_f32_16x16x32_bf16(bfr, af, acc, 0, 0, 0);
            }
            const int d = g * 64 + tn * 16 + fq * 4;
            const f32x4 ps = *(const f32x4*)(a.in[21] + l * 256 + d);
            u32x2 o; o.x = cvtpk(acc[0] * ps[0], acc[1] * ps[1]); o.y = cvtpk(acc[2] * ps[2], acc[3] * ps[3]);
            *(u32x2*)(MIX + (size_t)(row0 + tm * 16 + fr) * 1024 + 384 + d) = o;
        }
    }
    __syncthreads();
}

__device__ __forceinline__ void attention_phase(const Args& a, int ci, int l, LAS unsigned char* lds, int wv) {
    unsigned char* ws = a.ws;
    unsigned* ctr = (unsigned*)(ws + WS_CTL) + ci * 8;
    const float* lamv = (const float*)(ws + WS_CTL + 256);
    const float* lamp = lamv + l * 2;
    const bf16_t* U = (const bf16_t*)(ws + WS_U); const bf16_t* QC = (const bf16_t*)(ws + WS_QC); const bf16_t* KVX = (const bf16_t*)(ws + WS_KVX);
    const bf16_t* KR = (const bf16_t*)(ws + WS_KR); const bf16_t* KS = (const bf16_t*)(ws + WS_KS); const bf16_t* VS = (const bf16_t*)(ws + WS_VS);
    bf16_t* MIX = (bf16_t*)(ws + WS_MIX);
    LAS unsigned* qw = (LAS unsigned*)(lds + att::Q_OFF);
    constexpr int QS = 12, QP = 384, QPOOL = NGRP / 8, QLEN = QS + QP + QPOOL;
    const int myx = (int)((unsigned)__builtin_amdgcn_s_getreg((3 << 11) | 20) & 7u);
    int vic = 0;
    for (;;) {
        const int x = (myx + vic) & 7;
        if (otid(wv) == 0) *qw = atomicAdd(ctr + x, 1u);
        __syncthreads();
        const int qi = (int)*qw;
        __syncthreads();
        if (qi >= QLEN) { if (++vic >= 8) break; continue; }
        if (qi < QS) {
            const int ui = x * QS + qi;
            const int type = ui / 48, b = (ui % 48) / 6, h = ui % 6;
            const int qrow0 = MP + b * 64;
            if (type == 0) {
                att::Ptrs P{U + (size_t)qrow0 * INC + h * 64, INC, KS + (size_t)b * TKS * 384 + h * 64, 384, nullptr, VS + (size_t)b * TKS * 384 + h * 64, 384};
                att::attn_unit<0>(lds, P, 64, 65, PAST, true, h, a.in[19], lamp, a.in[18] + l * 64, MIX + (size_t)qrow0 * 1024 + h * 64, wv);
            } else {
                const size_t kv0 = (size_t)MP + (size_t)b * TKS;
                att::Ptrs P{QC + (size_t)qrow0 * 576 + h * 96, 576, KVX + kv0 * 768 + h * 128, 768, KR + kv0 * 32, KVX + kv0 * 768 + h * 128 + 64, 768};
                att::attn_unit<1>(lds, P, 64, 65, PAST, true, h, nullptr, lamp, nullptr, MIX + (size_t)qrow0 * 1024 + 640 + h * 64, wv);
            }
        } else if (qi < QS + QP) {
            const int i2 = qi - QS; const int pr = i2 >> 5, within = i2 & 31; const int qb = 15 - (within >> 1);
            const int stream = x * 24 + pr * 2 + (within & 1);
            const int type = stream / 96, bh = stream % 96, b = bh / 6, h = bh % 6;
            const int qrow0 = b * 4096 + qb * 256; const size_t kv0 = (size_t)b * 4096;
            if (type == 0) {
                att::Ptrs P{U + (size_t)qrow0 * INC + h * 64, INC, U + kv0 * INC + 384 + h * 64, INC, nullptr, U + kv0 * INC + 768 + h * 64, INC};
                att::attn_unit<0>(lds, P, 256, 4 * (qb + 1), qb * 256, false, h, a.in[19], lamp, a.in[18] + l * 64, MIX + (size_t)qrow0 * 1024 + h * 64, wv);
            } else {
                att::Ptrs P{QC + (size_t)qrow0 * 576 + h * 96, 576, KVX + kv0 * 768 + h * 128, 768, KR + kv0 * 32, KVX + kv0 * 768 + h * 128 + 64, 768};
                att::attn_unit<1>(lds, P, 256, 4 * (qb + 1), qb * 256, false, h, nullptr, lamp, nullptr, MIX + (size_t)qrow0 * 1024 + 640 + h * 64, wv);
            }
        } else {
            const int i3 = (qi - QS - QP) * 8 + x;
            pool_unit(a, l, i3, lds, wv);
        }
    }
}

__device__ __forceinline__ void fix_phase(const Args& a, int l, int wv) {
    const float* FIX = (const float*)(a.ws + WS_FIX);
    bf16_t* ACT = (bf16_t*)(a.ws + WS_ACT);
    const float* cw = a.in[29] + (size_t)l * 3 * FFN; const float* cb = a.in[30] + (size_t)l * FFN;
    const size_t gtid = (size_t)blockIdx.x * NTHREADS + otid(wv), gsz = (size_t)gridDim.x * NTHREADS;
    for (size_t i = gtid; i < (size_t)NGRP * (FFN / 4); i += gsz) {
        const int gi = (int)(i / (FFN / 4)), c = (int)(i % (FFN / 4)) * 4;
        const float* f = FIX + (size_t)gi * 6 * FFN + c;
        f32x4 h0, h1;
        if (gi >= MP / 64) { const float* hs = a.in[9] + ((size_t)l * NBS + (gi - MP / 64)) * 2 * FFN + c; h0 = *(const f32x4*)hs; h1 = *(const f32x4*)(hs + FFN); }
        else if ((gi & 63) == 0) { h0 = (f32x4){0.f, 0.f, 0.f, 0.f}; h1 = h0; }
        else { const float* fp = f - (size_t)6 * FFN; h0 = *(const f32x4*)(fp + (size_t)4 * FFN); h1 = *(const f32x4*)(fp + (size_t)5 * FFN); }
        const f32x4 g0 = *(const f32x4*)f, g1 = *(const f32x4*)(f + FFN), v0 = *(const f32x4*)(f + (size_t)2 * FFN), v1 = *(const f32x4*)(f + (size_t)3 * FFN);
        const f32x4 w0 = *(const f32x4*)(cw + c), w1 = *(const f32x4*)(cw + FFN + c), w2 = *(const f32x4*)(cw + 2 * FFN + c), bb = *(const f32x4*)(cb + c);
        float o0[4], o1[4];
#pragma unroll
        for (int e = 0; e < 4; ++e) {
            o0[e] = pg8::silu_f(w0[e] * h0[e] + w1[e] * h1[e] + w2[e] * g0[e] + bb[e]) * v0[e];
            o1[e] = pg8::silu_f(w0[e] * h1[e] + w1[e] * g0[e] + w2[e] * g1[e] + bb[e]) * v1[e];
        }
        u32x2 w; w.x = cvtpk(o0[0], o0[1]); w.y = cvtpk(o0[2], o0[3]);
        *(u32x2*)(ACT + (size_t)gi * 64 * FFN + c) = w;
        w.x = cvtpk(o1[0], o1[1]); w.y = cvtpk(o1[2], o1[3]);
        *(u32x2*)(ACT + ((size_t)gi * 64 + 1) * FFN + c) = w;
    }
}

__device__ __forceinline__ void final_phase(const Args& a, int wv, int row_lo, int row_hi, int bidx, int nblk) {
    const int tid_ = otid(wv); const int lane = tid_ & 63, wid = tid_ >> 6;
    const float* g = a.in[32];
    const int nw = nblk * 8;
    const int MT = row_hi;
    for (int rb = row_lo + bidx * 8 + wid; rb < MT; rb += nw * 4) {
        f32x4 v[4][4];
#pragma unroll
        for (int j = 0; j < 4; ++j) {
            const int row = rb + j * nw;
            if (row < MT) {
                const float* x = a.out + (size_t)row * DM;
#pragma unroll
                for (int i = 0; i < 4; ++i) v[j][i] = *(const f32x4*)(x + i * 256 + lane * 4);
            }
        }
#pragma unroll
        for (int j = 0; j < 4; ++j) {
            const int row = rb + j * nw;
            if (row < MT) {
                float* x = a.out + (size_t)row * DM;
                float ss = 0.f;
#pragma unroll
                for (int i = 0; i < 4; ++i) ss += v[j][i][0] * v[j][i][0] + v[j][i][1] * v[j][i][1] + v[j][i][2] * v[j][i][2] + v[j][i][3] * v[j][i][3];
                ss = wave_sum(ss);
                const float rstd = rsqrtf(ss * (1.f / 1024.f) + EPS);
#pragma unroll
                for (int i = 0; i < 4; ++i) { const int c = i * 256 + lane * 4; const f32x4 g4 = *(const f32x4*)(g + c); __builtin_nontemporal_store(v[j][i] * rstd * g4, (f32x4*)(x + c)); }
            }
        }
    }
}

constexpr int N_PHASES = 22;
#ifndef SKIPMASK
#define SKIPMASK 0
#endif
#define EN(k) (!((SKIPMASK >> (k)) & 1))
#ifndef DUPMASK
#define DUPMASK 0
#endif
#define REPS(k) ((((DUPMASK) >> (k)) & 1) ? 2 : 1)
__global__ void __launch_bounds__(NTHREADS, 2) mega_fwd(Args a) {
    extern __shared__ __attribute__((aligned(16))) unsigned char lds_raw[];
    LAS unsigned char* lds = (LAS unsigned char*)lds_raw;
    cg::grid_group grid = cg::this_grid();
    const int wv = __builtin_amdgcn_readfirstlane((int)threadIdx.x >> 6);
    const int lo = a.ph_lo, hi = a.ph_hi;
    unsigned char* ws = a.ws;
    const int G = gridDim.x, bx = blockIdx.x;
#define IN(k) (lo <= (k) && (k) < hi)
#define SEAM(k) do { if (IN(k) && IN((k) + 1)) xcd_barrier(xbar); } while (0)
    if (IN(0) && EN(0)) { prologue_phase(a, lds, wv); }
    grid.sync();
    XcdBarrier xbar;
    {
        volatile LAS unsigned* st = (volatile LAS unsigned*)(lds + LDS_BARST);
        { const int t_ = otid(wv); if (t_ < 2) st[t_] = 0u; }
        __syncthreads();
        xbar = xcd_barrier_post((unsigned*)(ws + WS_BAR), st, wv);
    }
#pragma unroll 1
    for (int l = 0; l < 2; ++l) {
        const int pb = 1 + 10 * l;
        const float* mod = (const float*)(ws + WS_MOD) + (size_t)l * 24 * 6144;
        if (l == 0) {
            if (IN(pb + 0) && EN(1)) { shw_phase(a, lds, wv); norm_phase(a, 0, 0, true, wv); }
            SEAM(pb + 0);
        }
        _Pragma("unroll 1") for (int rep = 0; rep < REPS(2); ++rep) { if (rep) xcd_barrier(xbar);
        if (IN(pb + 1) && EN(2)) {
            pg8::Gemm g{(const bf16_t*)(ws + WS_H), (const bf16_t*)(ws + WS_WIN) + (size_t)l * INPAD * 1024, MT, INPAD, 1024};
            pg8::StaticOrder S; S.init((G == 256) ? MP : MT, INPAD, G, bx);
            pg8::EpiInProj E{(bf16_t*)(ws + WS_U), a.out + O_AKP + (size_t)l * MP * 384, a.out + O_AKS + (size_t)l * MS * 384, a.out + O_AVP + (size_t)l * MP * 384, a.out + O_AVS + (size_t)l * MS * 384,
                             a.out + O_POOLP + (size_t)l * NBP * 15 * 256, a.out + O_POOLS + (size_t)l * NBS * 15 * 256,
                             l ? (const float*)(ws + WS_RS) + (size_t)1 * MT : nullptr, (const float*)(ws + WS_SHW1) + (size_t)l * 24 * INPAD};
            pg8::gemm_phase(lds, g, S, E, wv);
        }
        }
        SEAM(pb + 1);
        _Pragma("unroll 1") for (int rep = 0; rep < REPS(3); ++rep) { if (rep) xcd_barrier(xbar);
        if (IN(pb + 2) && EN(3)) {
            unsigned* cnt1 = (unsigned*)(ws + WS_CTL) + 52 + l;
            if (G == 256 && bx >= 240) {
                const int si = bx - 240;
                if (rep == 0) {
                    pg8::Gemm g1{(const bf16_t*)(ws + WS_H), (const bf16_t*)(ws + WS_WIN) + (size_t)l * INPAD * 1024, MT, INPAD, 1024};
                    pg8::OneUnit S1{256 + (si >> 3), si & 7};
                    pg8::EpiInProj E1{(bf16_t*)(ws + WS_U), a.out + O_AKP + (size_t)l * MP * 384, a.out + O_AKS + (size_t)l * MS * 384, a.out + O_AVP + (size_t)l * MP * 384, a.out + O_AVS + (size_t)l * MS * 384,
                                      a.out + O_POOLP + (size_t)l * NBP * 15 * 256, a.out + O_POOLS + (size_t)l * NBS * 15 * 256,
                                      l ? (const float*)(ws + WS_RS) + (size_t)1 * MT : nullptr, (const float*)(ws + WS_SHW1) + (size_t)l * 24 * INPAD};
                    pg8::gemm_phase(lds, g1, S1, E1, wv);
                    publish_count(cnt1, otid(wv));
                }
                wait_count(cnt1, 16u);
                post_phase(a, l, wv, MP + si * 32, MP + si * 32 + 32, 0, 1, false);
            } else if (G == 256) {
                post_phase(a, l, wv, 0, MP, bx, 240, true);
            } else {
                post_phase(a, l, wv, 0, MT, bx, G, true);
            }
        }
        }
        SEAM(pb + 2);
        _Pragma("unroll 1") for (int rep = 0; rep < REPS(4); ++rep) { if (rep) xcd_barrier(xbar);
        if (IN(pb + 3) && EN(4)) {
            {
                pg8::Gemm g{(const bf16_t*)(ws + WS_CQN), (const bf16_t*)(ws + WS_WQUP) + (size_t)l * 768 * 256, MT, 768, 256};
                pg8::StaticOrder S; S.init(MT, 768, G, bx);
                pg8::EpiQup E{(bf16_t*)(ws + WS_QC), (const float*)(ws + WS_ROPE)};
                pg8::gemm_phase(lds, g, S, E, wv);
            }
            {
                pg8::Gemm g{(const bf16_t*)(ws + WS_LAT), (const bf16_t*)(ws + WS_WKV) + (size_t)l * 768 * 128, MKV, 768, 128};
                pg8::StaticOrder S; S.init(MKV, 768, G, bx);
                pg8::EpiBf16 E{(bf16_t*)(ws + WS_KVX), 768};
                pg8::gemm_phase(lds, g, S, E, wv);
            }
        }
        }
        SEAM(pb + 3);
        _Pragma("unroll 1") for (int rep = 0; rep < REPS(5); ++rep) { if (rep) xcd_barrier(xbar);
        if (IN(pb + 4) && EN(5)) { attention_phase(a, l + 2 * rep, l, lds, wv); }
        }
        SEAM(pb + 4);
        _Pragma("unroll 1") for (int rep = 0; rep < REPS(6); ++rep) { if (rep) xcd_barrier(xbar);
        if (IN(pb + 5) && EN(6)) {
            pg8::Gemm g{(const bf16_t*)(ws + WS_MIX), (const bf16_t*)(ws + WS_WOUT) + (size_t)l * 1024 * 1024, MT, 1024, 1024};
            pg8::StaticOrder S; S.init(MP, 1024, G, bx);
            pg8::EpiRes E{a.in[0], a.in[1], l == 0, a.out, rep ? (float*)(ws + WS_U) : a.out, mod + 2048,
                          rep ? nullptr : (bf16_t*)(ws + WS_H), a.in[27] + l * 1024, mod + 4096, (float*)(ws + WS_RS) + (size_t)(rep ? 3 : (l ? 2 : 0)) * MT};
            pg8::gemm_phase(lds, g, S, E, wv);
        }
        }
        SEAM(pb + 5);
        _Pragma("unroll 1") for (int rep = 0; rep < REPS(8); ++rep) { if (rep) xcd_barrier(xbar);
        if (IN(pb + 7) && EN(8)) {
            unsigned* cnt3 = (unsigned*)(ws + WS_CTL) + 48 + l;
            if (rep == 0 && bx >= 48 && bx < 112 && (bx & 7) == 0) {
                const int si = (bx - 48) >> 3;
                pg8::Gemm g3{(const bf16_t*)(ws + WS_MIX), (const bf16_t*)(ws + WS_WOUT) + (size_t)l * 1024 * 1024, MT, 1024, 1024};
                pg8::OneUnit S1{256 + (si >> 2), si & 3};
                pg8::EpiRes E3{a.in[0], a.in[1], l == 0, a.out, a.out, mod + 2048,
                               (bf16_t*)(ws + WS_H), a.in[27] + l * 1024, mod + 4096, (float*)(ws + WS_RS) + (size_t)(l ? 2 : 0) * MT};
                pg8::gemm_phase(lds, g3, S1, E3, wv);
                publish_count(cnt3, otid(wv));
            }
            pg8::Gemm g{(const bf16_t*)(ws + WS_H), (const bf16_t*)(ws + WS_WUP) + (size_t)l * 5632 * 1024, MT, 5632, 1024};
            pg8::GatedOrder S; S.so.init(MT, 5632, G, bx); S.cnt = cnt3; S.need = 8u; S.gate_pm = 256;
            pg8::EpiUp E{(bf16_t*)(ws + WS_ACT), (float*)(ws + WS_FIX), a.in[29] + (size_t)l * 3 * FFN, a.in[30] + (size_t)l * FFN,
                         a.out + O_CONVP + (size_t)l * NBP * 2 * FFN, a.out + O_CONVS + (size_t)l * NBS * 2 * FFN,
                         (const float*)(ws + WS_RS) + (size_t)(l ? 2 : 0) * MT, (const float*)(ws + WS_SHW2) + (size_t)l * 24 * 5632};
            pg8::gemm_phase(lds, g, S, E, wv);
        }
        }
        SEAM(pb + 7);
        _Pragma("unroll 1") for (int rep = 0; rep < REPS(9); ++rep) { if (rep) xcd_barrier(xbar);
        if (IN(pb + 8) && EN(9)) { fix_phase(a, l, wv); }
        }
        SEAM(pb + 8);
        _Pragma("unroll 1") for (int rep = 0; rep < REPS(10); ++rep) { if (rep) xcd_barrier(xbar);
        if (IN(pb + 9) && EN(10)) {
            pg8::Gemm g{(const bf16_t*)(ws + WS_ACT), (const bf16_t*)(ws + WS_WDN) + (size_t)l * 1024 * FFN, MT, 1024, FFN};
            pg8::StaticOrder S; S.init(l == 0 ? MT : MP, 1024, G, bx);
            pg8::EpiRes E{a.in[0], a.in[1], false, a.out, rep ? (float*)(ws + WS_LAT) : a.out, mod + 5120,
                          (l == 0 && !rep) ? (bf16_t*)(ws + WS_H) : nullptr, a.in[12] + 1024, mod + 24 * 6144 + 1024, (float*)(ws + WS_RS) + (size_t)(rep ? 3 : 1) * MT};
            pg8::gemm_phase(lds, g, S, E, wv);
        }
        }
        SEAM(pb + 9);
    }
#ifdef PROBE_SYNCS
    for (int i = 0; i < PROBE_SYNCS; ++i) xcd_barrier(xbar);
#endif
    if (IN(21) && EN(11)) {
        unsigned* cnt5 = (unsigned*)(ws + WS_CTL) + 50;
        if (G == 256 && bx >= 248) {
            const int si = bx - 248;
            const float* mod1 = (const float*)(ws + WS_MOD) + (size_t)24 * 6144;
            pg8::Gemm g5{(const bf16_t*)(ws + WS_ACT), (const bf16_t*)(ws + WS_WDN) + (size_t)1024 * FFN, MT, 1024, FFN};
            pg8::OneUnit S1{256 + (si >> 2), si & 3};
            pg8::EpiRes E5{a.in[0], a.in[1], false, a.out, a.out, mod1 + 5120, nullptr, a.in[12], mod1, (float*)(ws + WS_RS)};
            pg8::gemm_phase(lds, g5, S1, E5, wv);
            publish_count(cnt5, otid(wv));
            wait_count(cnt5, 8u);
            final_phase(a, wv, MP + si * 64, MP + si * 64 + 64, 0, 1);
        } else if (G == 256) {
            final_phase(a, wv, 0, MP, bx, 248);
        } else {
            final_phase(a, wv, 0, MT, bx, G);
        }
    }
#undef IN
#undef SEAM
}

extern "C" void kernel_launch(void* const* d_in, const int* in_sizes, int n_in, void* d_out, int out_size, void* d_ws, size_t ws_size, hipStream_t stream) {
    static int grid = 0;
    if (grid == 0) {
        if (n_in != 33 || (size_t)out_size != O_END || ws_size < WS_END) { fprintf(stderr, "kernel_launch: unexpected shapes: n_in %d out %d ws %zu (need %zu)\n", n_in, out_size, ws_size, (size_t)WS_END); grid = -1; return; }
        int dev = 0, cus = 0, per_cu = 0;
        hipGetDevice(&dev);
        hipDeviceGetAttribute(&cus, hipDeviceAttributeMultiprocessorCount, dev);
        if (hipFuncSetAttribute((const void*)mega_fwd, hipFuncAttributeMaxDynamicSharedMemorySize, LDS_BYTES) != hipSuccess) { fprintf(stderr, "kernel_launch: hipFuncSetAttribute failed\n"); grid = -1; return; }
        if (hipOccupancyMaxActiveBlocksPerMultiprocessor(&per_cu, (const void*)mega_fwd, NTHREADS, LDS_BYTES) != hipSuccess || per_cu < 1) { fprintf(stderr, "kernel_launch: occupancy query gave %d\n", per_cu); per_cu = 1; }
        (void)hipGetLastError();
        grid = cus * 1;
        if (grid <= 0) grid = 256;
    }
    if (grid < 0) return;
    Args a{};
    for (int i = 0; i < 33; ++i) a.in[i] = (const float*)d_in[i];
    a.out = (float*)d_out; a.ws = (unsigned char*)d_ws;
    for (int i = 0; i < 16; ++i) a.inv_freq[i] = 1.0f / powf(10000.0f, (float)i / 16.0f);
#if N_LAUNCH_MODE == 1
    a.ph_lo = 0; a.ph_hi = N_PHASES;
    void* args[] = {&a};
    hipError_t e = hipLaunchCooperativeKernel((const void*)mega_fwd, dim3(grid), dim3(NTHREADS), args, LDS_BYTES, stream);
    if (e != hipSuccess) fprintf(stderr, "cooperative launch failed: %s (grid %d)\n", hipGetErrorString(e), grid);
#else
    for (int p = 0; p < N_PHASES; ++p) {
        a.ph_lo = p; a.ph_hi = p + 1;
        hipLaunchKernelGGL(mega_fwd, dim3(grid), dim3(NTHREADS), LDS_BYTES, stream, a);
    }
#endif
}
```
